# Optimizing an MI355X kernel written in HIP

```python
import jax, jax.numpy as jnp
from jax import lax
import numpy as np

D_MODEL = 2048
BATCH = 1
SEQ = 16384
DEPTH = 1

N_HEADS = 16
Q_LORA_RANK = 512
KV_LORA_RANK = 512
QK_NOPE_DIM = 128
QK_ROPE_DIM = 64
V_HEAD_DIM = 128
ROPE_THETA = 10000.0
ATTN_WIDTH = N_HEADS * V_HEAD_DIM
Q_BLOCK = 128
POOL_WIDTH = D_MODEL // 2
POOL_WINDOWS = (2, 4, 8, 16)
POOL_GROUPS = len(POOL_WINDOWS)
POOL_GROUP_DIM = POOL_WIDTH // POOL_GROUPS
N_MEM = 256
MEM_HEADS = 4
MEM_HEAD_DIM = D_MODEL // MEM_HEADS
D_FF = 5632
CONV_WIDTH = 3
EPS = 1e-6
IN_SIZES = (Q_LORA_RANK, KV_LORA_RANK, QK_ROPE_DIM, POOL_WIDTH, D_MODEL, D_MODEL)
D_IN = Q_LORA_RANK + KV_LORA_RANK + QK_ROPE_DIM + POOL_WIDTH + 2 * D_MODEL

kernel_name = "hybrid_mla_pool_memxattn_convffn"


def rmsnorm(x, g):
    xf = x.astype(jnp.float32)
    y = xf * lax.rsqrt(jnp.mean(xf * xf, axis=-1, keepdims=True) + EPS)
    return (y * g.astype(jnp.float32)).astype(x.dtype)


def rope_tables(positions, dtype):
    inv_freq = ROPE_THETA ** (-jnp.arange(0, QK_ROPE_DIM, 2, dtype=jnp.float32) / QK_ROPE_DIM)
    ang = positions.astype(jnp.float32)[..., None] * inv_freq
    return jnp.cos(ang).astype(dtype), jnp.sin(ang).astype(dtype)


def apply_rope(x, cos, sin):
    half = QK_ROPE_DIM // 2
    x1, x2 = x[..., :half], x[..., half:]
    return jnp.concatenate([x1 * cos - x2 * sin, x2 * cos + x1 * sin], axis=-1)


def split_cols(z, sizes):
    outs, start = [], 0
    for n in sizes:
        outs.append(z[..., start:start + n])
        start += n
    return outs


def mla_branch(q_lat, c_kv, k_pe, positions, g_q_a, w_q_b, g_kv_a, w_kv_b):
    B, S, _ = q_lat.shape
    q = (rmsnorm(q_lat, g_q_a) @ w_q_b).reshape(B, S, N_HEADS, QK_NOPE_DIM + QK_ROPE_DIM)
    q_nope, q_pe = q[..., :QK_NOPE_DIM], q[..., QK_NOPE_DIM:]
    kv = (rmsnorm(c_kv, g_kv_a) @ w_kv_b).reshape(B, S, N_HEADS, QK_NOPE_DIM + V_HEAD_DIM)
    k_nope, v = kv[..., :QK_NOPE_DIM], kv[..., QK_NOPE_DIM:]
    cos, sin = rope_tables(positions, q.dtype)
    q_pe = apply_rope(q_pe, cos[:, :, None, :], sin[:, :, None, :])
    k_pe = apply_rope(k_pe, cos, sin)
    scale = (QK_NOPE_DIM + QK_ROPE_DIM) ** -0.5
    nb = S // Q_BLOCK
    qn_b = q_nope.reshape(B, nb, Q_BLOCK, N_HEADS, QK_NOPE_DIM).transpose(1, 0, 3, 2, 4)
    qp_b = q_pe.reshape(B, nb, Q_BLOCK, N_HEADS, QK_ROPE_DIM).transpose(1, 0, 3, 2, 4)
    kn = k_nope.transpose(0, 2, 1, 3)
    vh = v.transpose(0, 2, 1, 3)
    key_idx = jnp.arange(S)

    def query_block(args):
        qn, qp, i = args
        s = (jnp.einsum('bhqd,bhkd->bhqk', qn, kn)
             + jnp.einsum('bhqr,bkr->bhqk', qp, k_pe)).astype(jnp.float32) * scale
        q_idx = i * Q_BLOCK + jnp.arange(Q_BLOCK)
        s = jnp.where(key_idx[None, :] <= q_idx[:, None], s, -jnp.inf)
        p = jax.nn.softmax(s, axis=-1).astype(vh.dtype)
        return jnp.einsum('bhqk,bhkd->bhqd', p, vh)

    o = lax.map(query_block, (qn_b, qp_b, jnp.arange(nb)))
    return o.transpose(1, 0, 3, 2, 4).reshape(B, S, ATTN_WIDTH)


def pool_branch(u, w_pool_grp, pool_scale):
    B, S, _ = u.shape
    ug = u.reshape(B, S, POOL_GROUPS, POOL_GROUP_DIM).astype(jnp.float32)
    cs = jnp.concatenate([jnp.zeros((B, 1, POOL_GROUPS, POOL_GROUP_DIM), jnp.float32),
                          jnp.cumsum(ug, axis=1)], axis=1)
    t = jnp.arange(S)
    outs = []
    for g, w in enumerate(POOL_WINDOWS):
        lo = jnp.maximum(t + 1 - w, 0)
        win_sum = cs[:, 1:, g] - cs[:, lo, g]
        cnt = jnp.minimum(t + 1, w).astype(jnp.float32)[None, :, None]
        outs.append(win_sum / cnt - ug[:, :, g])
    d = jnp.stack(outs, axis=2).astype(u.dtype)
    y = jnp.einsum('bsgc,gcd->bsgd', d, w_pool_grp).reshape(B, S, POOL_WIDTH)
    return y * pool_scale


def memory_xattn(h, mem_n, w_mem_q, w_mem_kv, w_mem_o):
    B, S, _ = h.shape
    q = (h @ w_mem_q).reshape(B, S, MEM_HEADS, MEM_HEAD_DIM)
    kv = (mem_n @ w_mem_kv).reshape(B, N_MEM, 2, MEM_HEADS, MEM_HEAD_DIM)
    k, v = kv[:, :, 0], kv[:, :, 1]
    s = jnp.einsum('bqhd,bkhd->bhqk', q, k).astype(jnp.float32) * (MEM_HEAD_DIM ** -0.5)
    p = jax.nn.softmax(s, axis=-1).astype(v.dtype)
    o = jnp.einsum('bhqk,bkhd->bqhd', p, v).reshape(B, S, D_MODEL)
    return o @ w_mem_o


def conv_gated_ffn(h, w_ffn_in, conv_w, conv_b, w_ffn_out):
    S = h.shape[1]
    a = h @ w_ffn_in
    ap = jnp.pad(a, ((0, 0), (CONV_WIDTH - 1, 0), (0, 0)))
    c = conv_b
    for k in range(CONV_WIDTH):
        c = c + ap[:, k:k + S] * conv_w[k]
    gate, up = c[..., :D_FF], c[..., D_FF:]
    return (jax.nn.gelu(gate, approximate=True) * up) @ w_ffn_out


def setup_inputs(seed: int = 0) -> dict:
    key = jax.random.key(seed)
    ks = iter(jax.random.split(key, 40))
    L = DEPTH

    def w(shape, fan_in):
        return jax.random.normal(next(ks), shape, jnp.float32) * fan_in ** -0.5

    def gain(shape):
        return 1.0 + 0.05 * jax.random.normal(next(ks), shape, jnp.float32)

    x = jax.random.normal(next(ks), (BATCH, SEQ, D_MODEL), jnp.float32)
    mem = jax.random.normal(next(ks), (BATCH, N_MEM, D_MODEL), jnp.float32)
    offset = jax.random.randint(next(ks), (BATCH, 1), 0, 4096, jnp.int32)
    positions = (offset + jnp.arange(SEQ, dtype=jnp.int32)[None, :]).astype(jnp.int32)
    return {
        "x": x,
        "mem": mem,
        "positions": positions,
        "g_mix_pre": gain((L, D_MODEL)),
        "w_in": w((L, D_MODEL, D_IN), D_MODEL),
        "g_q_a": gain((L, Q_LORA_RANK)),
        "w_q_b": w((L, Q_LORA_RANK, N_HEADS * (QK_NOPE_DIM + QK_ROPE_DIM)), Q_LORA_RANK),
        "g_kv_a": gain((L, KV_LORA_RANK)),
        "w_kv_b": w((L, KV_LORA_RANK, N_HEADS * (QK_NOPE_DIM + V_HEAD_DIM)), KV_LORA_RANK),
        "w_attn_br": w((L, ATTN_WIDTH, D_MODEL), ATTN_WIDTH),
        "w_pool_grp": w((L, POOL_GROUPS, POOL_GROUP_DIM, POOL_GROUP_DIM), POOL_GROUP_DIM),
        "pool_scale": gain((L, POOL_WIDTH)),
        "w_pool_br": w((L, POOL_WIDTH, D_MODEL), POOL_WIDTH),
        "w_mix_out": w((L, D_MODEL, D_MODEL), D_MODEL),
        "g_mix_post": gain((L, D_MODEL)),
        "g_mem_pre": gain((L, D_MODEL)),
        "g_mem_kv": gain((L, D_MODEL)),
        "w_mem_q": w((L, D_MODEL, D_MODEL), D_MODEL),
        "w_mem_kv": w((L, D_MODEL, 2 * D_MODEL), D_MODEL),
        "w_mem_o": w((L, D_MODEL, D_MODEL), D_MODEL),
        "g_mem_post": gain((L, D_MODEL)),
        "g_ffn_pre": gain((L, D_MODEL)),
        "w_ffn_in": w((L, D_MODEL, 2 * D_FF), D_MODEL),
        "conv_w": w((L, CONV_WIDTH, 2 * D_FF), CONV_WIDTH),
        "conv_b": 0.01 * jax.random.normal(next(ks), (L, 2 * D_FF), jnp.float32),
        "w_ffn_out": w((L, D_FF, D_MODEL), D_FF),
        "g_ffn_post": gain((L, D_MODEL)),
    }


def reference(x, mem, positions, g_mix_pre, w_in, g_q_a, w_q_b, g_kv_a, w_kv_b,
              w_attn_br, w_pool_grp, pool_scale, w_pool_br, w_mix_out, g_mix_post,
              g_mem_pre, g_mem_kv, w_mem_q, w_mem_kv, w_mem_o, g_mem_post,
              g_ffn_pre, w_ffn_in, conv_w, conv_b, w_ffn_out, g_ffn_post):
    for l in range(DEPTH):
        h = rmsnorm(x, g_mix_pre[l])
        z = h @ w_in[l]
        q_lat, c_kv, k_pe, u_pool, gate_a, gate_p = split_cols(z, IN_SIZES)
        y_a = mla_branch(q_lat, c_kv, k_pe, positions, g_q_a[l], w_q_b[l],
                         g_kv_a[l], w_kv_b[l]) @ w_attn_br[l]
        y_p = pool_branch(u_pool, w_pool_grp[l], pool_scale[l]) @ w_pool_br[l]
        merged = jax.nn.sigmoid(gate_a) * y_a + jax.nn.sigmoid(gate_p) * y_p
        x = x + rmsnorm(merged @ w_mix_out[l], g_mix_post[l])
        h = rmsnorm(x, g_mem_pre[l])
        mem_n = rmsnorm(mem, g_mem_kv[l])
        x = x + rmsnorm(memory_xattn(h, mem_n, w_mem_q[l], w_mem_kv[l], w_mem_o[l]),
                        g_mem_post[l])
        h = rmsnorm(x, g_ffn_pre[l])
        x = x + rmsnorm(conv_gated_ffn(h, w_ffn_in[l], conv_w[l], conv_b[l], w_ffn_out[l]),
                        g_ffn_post[l])
    return x
```

```cpp
#include <hip/hip_runtime.h>
#include <hip/hip_cooperative_groups.h>
#include <cstdio>
#include <cstdint>
#include <cmath>
namespace cg = cooperative_groups;

#define LAS __attribute__((address_space(3)))
typedef unsigned short bf16_t;
typedef short bf16x8 __attribute__((ext_vector_type(8)));
typedef short s16x4 __attribute__((ext_vector_type(4)));
typedef float f32x4 __attribute__((ext_vector_type(4)));
typedef float f32x2 __attribute__((ext_vector_type(2)));
typedef float f32x16 __attribute__((ext_vector_type(16)));
typedef unsigned u32x4 __attribute__((ext_vector_type(4)));
typedef unsigned u32x2 __attribute__((ext_vector_type(2)));

constexpr int S_ = 16384, DM = 2048, DIN = 6208, DINP = 6400, QL = 512;
constexpr int NH = 16, DQK = 192, DN = 128, DR = 64, DV = 128, QW = NH * DQK  , KVW = NH * 256  ;
constexpr int PW = 1024, NMEM = 256, MHD = 512, DFF = 5632, FF2 = 11264, FFH = 2816;
constexpr float EPS = 1e-6f;
constexpr int NTHREADS = 512, NWAVES = 8;

constexpr size_t MiB = 1u << 20;
constexpr size_t WS_W_IN = 0, WS_W_QB = 25 * MiB, WS_W_KVB = 28 * MiB, WS_W_ATT = 32 * MiB, WS_W_PG = 40 * MiB, WS_W_PBR = 41 * MiB,
                 WS_W_MIX = 45 * MiB, WS_W_MQ = 53 * MiB, WS_W_MKV = 61 * MiB, WS_W_MO = 77 * MiB, WS_W_FIN = 85 * MiB, WS_W_FOUT = 129 * MiB;
constexpr size_t WS_ROPE = 151 * MiB, WS_STAT = 155 * MiB, WS_KPE = 157 * MiB, WS_MEMN = 159 * MiB;
constexpr size_t WS_MEMK = 0, WS_VMT = 1 * MiB;
constexpr size_t WS_H3 = 0;
constexpr size_t WS_QC = 160 * MiB, WS_U = 192 * MiB, WS_GA = 224 * MiB, WS_GP = 288 * MiB, WS_D = 352 * MiB, WS_KV = 384 * MiB;
constexpr size_t WS_AO = 160 * MiB, WS_MERGED = 352 * MiB, WS_MO = 160 * MiB, WS_H2 = 288 * MiB, WS_QM = 352 * MiB, WS_PM = 416 * MiB;
constexpr size_t WS_OM = 160 * MiB, WS_MO2 = 224 * MiB, WS_AH = 160 * MiB, WS_ACT = 336 * MiB, WS_MO3 = 160 * MiB;
constexpr size_t WS_END = 512 * MiB;
constexpr size_t DO_H = 0, DO_Q = 0, DO_PD = 96 * MiB;

typedef __bf16 bf16x2_t __attribute__((ext_vector_type(2)));
__device__ __forceinline__ unsigned cvt_pk(float lo, float hi) { f32x2 v = {lo, hi}; bf16x2_t b = __builtin_convertvector(v, bf16x2_t); return __builtin_bit_cast(unsigned, b); }
__device__ __forceinline__ float bf_lo(unsigned u) { return __uint_as_float(u << 16); }
__device__ __forceinline__ float bf_hi(unsigned u) { return __uint_as_float(u & 0xffff0000u); }
__device__ __forceinline__ u32x4 pack8(f32x4 a, f32x4 b) { u32x4 w; w.x = cvt_pk(a[0], a[1]); w.y = cvt_pk(a[2], a[3]); w.z = cvt_pk(b[0], b[1]); w.w = cvt_pk(b[2], b[3]); return w; }
__device__ __forceinline__ void unpack8(u32x4 w, f32x4& a, f32x4& b) { a = (f32x4){bf_lo(w.x), bf_hi(w.x), bf_lo(w.y), bf_hi(w.y)}; b = (f32x4){bf_lo(w.z), bf_hi(w.z), bf_lo(w.w), bf_hi(w.w)}; }
__device__ __forceinline__ float sigmoidf_(float x) { return __builtin_amdgcn_rcpf(1.f + __expf(-x)); }
__device__ __forceinline__ float wave_sum(float v) {
#pragma unroll
    for (int o = 1; o < 64; o <<= 1) v += __shfl_xor(v, o);
    return v;
}
#define LDS_WAIT() asm volatile("s_waitcnt lgkmcnt(0)" ::: "memory")
__device__ __forceinline__ int fresh_tid() { int t = threadIdx.x; asm volatile("" : "+v"(t)); return t; }

namespace pg8 {
constexpr int BM = 256, BK = 64, HALF = 128, HTB = HALF * BK * 2, STAGE_BYTES = 8 * HTB, NXCD = 8, WGM = 8;
__host__ __device__ __forceinline__ int lds_byte(int r, int c) { const int st = (r >> 4) * 2 + (c >> 5), rr = r & 15, cc = c & 31, ob = rr * 64 + cc * 2; return st * 1024 + (ob ^ (((ob >> 9) & 1) << 5)); }
__host__ __device__ __forceinline__ void stage_rc(int b, int& R, int& C) { const int st = b / 1024, sb = b % 1024, swz = sb ^ (((sb >> 9) & 1) << 5); R = (st >> 1) * 16 + swz / 64; C = (st & 1) * 32 + (swz % 64) / 2; }
__host__ __device__ __forceinline__ int perm32(int rho) { const int n = rho >> 4, i = rho & 15; return 8 * (i >> 2) + 4 * n + (i & 3); }

struct Unit { int pm, pn; };
struct Gemm { const bf16_t* A; const bf16_t* Bt; int lda, ldb, K; };

struct Order {
    int nM, nN, nwg, G, c;
    __device__ __forceinline__ void init(int nM_, int nN_, int G_, int bid, int rot) { nM = nM_; nN = nN_; nwg = nM * nN; G = G_; c = (bid + G_ - (rot % G_)) % G_; }
    __device__ __forceinline__ bool next(int i, Unit& u) const {
        const long L = (long)i * G + c; if (L >= nwg) return false;
        int wgid = (int)L; { const int q = nwg / NXCD, r = nwg % NXCD, xcd = wgid % NXCD, off = wgid / NXCD; wgid = (xcd < r ? xcd * (q + 1) : r * (q + 1) + (xcd - r) * q) + off; }
        const int nig = WGM * nN, gid = wgid / nig, fm = gid * WGM, gsz = (nM - fm) < WGM ? (nM - fm) : WGM;
        u.pm = fm + ((wgid % nig) % gsz); u.pn = (wgid % nig) / gsz; return true;
    }
};

template <class Epi, bool APERM = false, bool NARROW = false>
__device__ __forceinline__ void gemm_phase(LAS unsigned char* lds, const Gemm g, const Order& S, const Epi& E) {
    const int tid = fresh_tid(), wid = __builtin_amdgcn_readfirstlane(tid >> 6), lane = tid & 63, wr = wid >> 2, wc = wid & 3, fr = lane & 15, fq = lane >> 4;
    const int K = g.K, nt = K / BK;
    unsigned voffA[2], voffB[2];
#pragma unroll
    for (int i = 0; i < 2; ++i) { int R, C; stage_rc(tid * 16 + i * 8192, R, C); const int Rb = (R & ~31) + perm32(R & 31);
        const int Ra = APERM ? ((R & ~63) + 4 * (R & 15) + ((R >> 4) & 3)) : R;
        voffA[i] = (unsigned)(Ra * g.lda + C) * 2u; voffB[i] = (unsigned)(Rb * g.ldb + C) * 2u; }
    const size_t kstep = (size_t)(BK * 2);
    const size_t hstepA = (size_t)HALF * g.lda * 2, hstepB = (size_t)HALF * g.ldb * 2;
    const size_t tstepA = 2 * hstepA, tstepB = 2 * hstepB;
    const unsigned ldsw = (unsigned)wid * 1024u;
    const int aoff = lds_byte(wr * 64 + fr, fq * 8), boff = lds_byte(wc * 32 + fr, fq * 8);
#define PG8_SA(b, h) (((b) * 2 + (h)) * HTB)
#define PG8_SB(b, h) ((4 + (b) * 2 + (h)) * HTB)
#define PG8_STAGE(bufoff, gbase, voff) do { _Pragma("unroll") for (int _i = 0; _i < 2; ++_i) \
        __builtin_amdgcn_global_load_lds((const unsigned*)((const char*)(gbase) + (voff)[_i]), (LAS unsigned*)(lds + (bufoff) + ldsw + _i * 8192), 16, 0, 0); } while (0)
#define PG8_LDA(dst, b, h) do { _Pragma("unroll") for (int m = 0; m < 4; ++m) _Pragma("unroll") for (int k = 0; k < 2; ++k) dst[m][k] = *(const LAS bf16x8*)(lds + PG8_SA(b, h) + aoff + m * 2048 + k * 1024); } while (0)
#define PG8_LDB(dst, b, h) do { _Pragma("unroll") for (int n = 0; n < 2; ++n) _Pragma("unroll") for (int k = 0; k < 2; ++k) dst[n][k] = *(const LAS bf16x8*)(lds + PG8_SB(b, h) + boff + n * 2048 + k * 1024); } while (0)
#define PG8_MMA(ai, bj, At, Bt) do { __builtin_amdgcn_s_setprio(1); _Pragma("unroll") for (int m = 0; m < 4; ++m) _Pragma("unroll") for (int n = 0; n < 2; ++n) _Pragma("unroll") for (int k = 0; k < 2; ++k) \
        acc[ai][bj][m][n] = __builtin_amdgcn_mfma_f32_16x16x32_bf16(Bt[n][k], At[m][k], acc[ai][bj][m][n], 0, 0, 0); __builtin_amdgcn_s_setprio(0); } while (0)
#define PG8_WAIT_V(n) asm volatile("s_waitcnt vmcnt(" #n ")" ::: "memory")
#define PG8_WAIT_L(n) asm volatile("s_waitcnt lgkmcnt(" #n ")" ::: "memory")
#define PG8_BAR __builtin_amdgcn_s_barrier()
#define PG8_SCHED __builtin_amdgcn_sched_barrier(0)
    Unit cur, nxt; int ui = 0;
    if (!S.next(0, cur)) return;
    f32x4 acc[2][2][4][2];
#pragma unroll
    for (int a = 0; a < 2; ++a)
#pragma unroll
        for (int b = 0; b < 2; ++b)
#pragma unroll
            for (int m = 0; m < 4; ++m)
#pragma unroll
                for (int n = 0; n < 2; ++n) acc[a][b][m][n] = (f32x4){0.f, 0.f, 0.f, 0.f};
    bf16x8 At[4][2], B0[2][2], B1[2][2];
    const char* cA = (const char*)g.A + (size_t)cur.pm * tstepA; const char* cB = (const char*)g.Bt + (size_t)cur.pn * tstepB;
    PG8_STAGE(PG8_SB(0, 0), cB, voffB); PG8_STAGE(PG8_SB(0, 1), cB + hstepB, voffB); PG8_STAGE(PG8_SA(0, 0), cA, voffA); PG8_STAGE(PG8_SA(0, 1), cA + hstepA, voffA);
    if (wr == 1) PG8_BAR;
    PG8_WAIT_V(2); PG8_BAR;
    PG8_STAGE(PG8_SB(1, 0), cB + kstep, voffB); PG8_STAGE(PG8_SA(1, 0), cA + kstep, voffA); PG8_STAGE(PG8_SB(1, 1), cB + hstepB + kstep, voffB);
    PG8_WAIT_V(6); PG8_BAR;
    for (;;) {
        const bool has_next = S.next(ui + 1, nxt);
        bool live0 = true, live1 = true; if constexpr (NARROW) { if (cur.pn == Epi::NARROW_PN) { live1 = false; live0 = wc < 2; } }
        const char* nA = has_next ? (const char*)g.A + (size_t)nxt.pm * tstepA : cA; const char* nB = has_next ? (const char*)g.Bt + (size_t)nxt.pn * tstepB : cB;
        for (int t = 0; t < nt; t += 2) {
            const bool last = (t == nt - 2);
            const char* a1 = cA + (size_t)(t + 1) * kstep;
            const char* a2 = last ? nA : cA + (size_t)(t + 2) * kstep; const char* b2 = last ? nB : cB + (size_t)(t + 2) * kstep;
            const char* a3 = a2 + kstep; const char* b3 = b2 + kstep;
            PG8_LDB(B0, 0, 0); PG8_LDB(B1, 0, 1); PG8_SCHED; PG8_LDA(At, 0, 0); PG8_STAGE(PG8_SA(1, 1), a1 + hstepA, voffA);
            PG8_WAIT_V(8); PG8_WAIT_L(0); PG8_BAR; if (live0) PG8_MMA(0, 0, At, B0); if (live1) PG8_MMA(0, 1, At, B1); PG8_BAR; PG8_SCHED;
            PG8_LDA(At, 0, 1); PG8_STAGE(PG8_SB(0, 0), b2, voffB); PG8_STAGE(PG8_SB(0, 1), b2 + hstepB, voffB); PG8_STAGE(PG8_SA(0, 0), a2, voffA);
            PG8_WAIT_V(8); PG8_WAIT_L(0); PG8_BAR; if (live0) PG8_MMA(1, 0, At, B0); if (live1) PG8_MMA(1, 1, At, B1); PG8_BAR; PG8_SCHED;
            PG8_LDB(B0, 1, 0); PG8_LDB(B1, 1, 1); PG8_SCHED; PG8_LDA(At, 1, 0); PG8_STAGE(PG8_SA(0, 1), a2 + hstepA, voffA);
            PG8_WAIT_V(8); PG8_WAIT_L(0); PG8_BAR; if (live0) PG8_MMA(0, 0, At, B0); if (live1) PG8_MMA(0, 1, At, B1); PG8_BAR; PG8_SCHED;
            PG8_LDA(At, 1, 1); PG8_STAGE(PG8_SB(1, 0), b3, voffB); PG8_STAGE(PG8_SB(1, 1), b3 + hstepB, voffB); PG8_STAGE(PG8_SA(1, 0), a3, voffA);
            PG8_WAIT_V(8); PG8_WAIT_L(0); PG8_BAR; if (live0) PG8_MMA(1, 0, At, B0); if (live1) PG8_MMA(1, 1, At, B1); PG8_BAR; PG8_SCHED;
        }
        if (wr == 0) PG8_BAR;
        E(acc, cur, wr, wc, fr, fq);
        if (!has_next) break;
#pragma unroll
        for (int a = 0; a < 2; ++a)
#pragma unroll
            for (int b = 0; b < 2; ++b)
#pragma unroll
                for (int m = 0; m < 4; ++m)
#pragma unroll
                    for (int n = 0; n < 2; ++n) acc[a][b][m][n] = (f32x4){0.f, 0.f, 0.f, 0.f};
        cur = nxt; cA = nA; cB = nB; ++ui;
        if (wr == 1) PG8_BAR;
    }
    PG8_WAIT_V(0);
    PG8_BAR;
#undef PG8_SA
#undef PG8_SB
#undef PG8_STAGE
#undef PG8_LDA
#undef PG8_LDB
#undef PG8_MMA
#undef PG8_WAIT_V
#undef PG8_WAIT_L
#undef PG8_BAR
#undef PG8_SCHED
}
}
using pg8::Unit;
typedef f32x4 Acc[2][2][4][2];

#define EPI_ARGS const Acc& acc, const Unit& u, int wr, int wc, int fr, int fq
#define EPI_ROWCOL const int row0 = u.pm * 256 + wr * 64 + fr; const int ct0 = wc * 32 + 8 * fq;

struct EpiStore {
    bf16_t* O; int ldo; int coff;
    __device__ __forceinline__ void operator()(EPI_ARGS) const { EPI_ROWCOL
#pragma unroll
        for (int ai = 0; ai < 2; ++ai)
#pragma unroll
            for (int m = 0; m < 4; ++m) { bf16_t* rp = O + (size_t)(row0 + ai * 128 + m * 16) * ldo + coff + u.pn * 256 + ct0;
#pragma unroll
                for (int bj = 0; bj < 2; ++bj) *(u32x4*)(rp + bj * 128) = pack8(acc[ai][bj][m][0], acc[ai][bj][m][1]); }
    }
};
struct EpiIn {
    static constexpr int NARROW_PN = 4;
    bf16_t *QC, *U, *GA, *GP, *KPE; float* STAT; const f32x2* ROPE;
    __device__ __forceinline__ void operator()(EPI_ARGS) const { EPI_ROWCOL
        const int pn = u.pn;
        if (pn < 4) {
#pragma unroll
            for (int ai = 0; ai < 2; ++ai)
#pragma unroll
                for (int m = 0; m < 4; ++m) { const int row = row0 + ai * 128 + m * 16; float s = 0.f;
#pragma unroll
                    for (int bj = 0; bj < 2; ++bj) { const f32x4 v0 = acc[ai][bj][m][0], v1 = acc[ai][bj][m][1];
                        s += (v0[0] * v0[0] + v0[1] * v0[1]) + (v0[2] * v0[2] + v0[3] * v0[3]) + (v1[0] * v1[0] + v1[1] * v1[1]) + (v1[2] * v1[2] + v1[3] * v1[3]);
                        *(u32x4*)(QC + (size_t)row * 1024 + pn * 256 + bj * 128 + ct0) = pack8(v0, v1); }
                    s += __shfl_xor(s, 16); s += __shfl_xor(s, 32);
                    if (fq == 0) STAT[(size_t)row * 32 + pn * 4 + wc] = s; }
        } else if (pn == 4) {
            if (wc < 2) { const int i0 = 16 * wc + 4 * fq;
#pragma unroll
                for (int ai = 0; ai < 2; ++ai)
#pragma unroll
                    for (int m = 0; m < 4; ++m) { const int row = row0 + ai * 128 + m * 16; const f32x4 v0 = acc[ai][0][m][0], v1 = acc[ai][0][m][1];
                        const f32x4 cs0 = *(const f32x4*)(ROPE + (size_t)row * 32 + i0), cs1 = *(const f32x4*)(ROPE + (size_t)row * 32 + i0 + 2);
                        const float a0 = v0[0] * cs0[0] - v0[1] * cs0[1], b0 = v0[1] * cs0[0] + v0[0] * cs0[1];
                        const float a1 = v0[2] * cs0[2] - v0[3] * cs0[3], b1 = v0[3] * cs0[2] + v0[2] * cs0[3];
                        const float a2 = v1[0] * cs1[0] - v1[1] * cs1[1], b2 = v1[1] * cs1[0] + v1[0] * cs1[1];
                        const float a3 = v1[2] * cs1[2] - v1[3] * cs1[3], b3 = v1[3] * cs1[2] + v1[2] * cs1[3];
                        u32x2 wa, wb; wa.x = cvt_pk(a0, a1); wa.y = cvt_pk(a2, a3); wb.x = cvt_pk(b0, b1); wb.y = cvt_pk(b2, b3);
                        *(u32x2*)(KPE + (size_t)row * 64 + i0) = wa; *(u32x2*)(KPE + (size_t)row * 64 + 32 + i0) = wb; } }
        } else if (pn < 9) {
#pragma unroll
            for (int ai = 0; ai < 2; ++ai)
#pragma unroll
                for (int m = 0; m < 4; ++m) { const int row = row0 + ai * 128 + m * 16;
#pragma unroll
                    for (int bj = 0; bj < 2; ++bj) *(u32x4*)(U + (size_t)row * 1024 + (pn - 5) * 256 + bj * 128 + ct0) = pack8(acc[ai][bj][m][0], acc[ai][bj][m][1]); }
        } else {
            bf16_t* G = pn < 17 ? GA : GP; const int pc = (pn < 17 ? pn - 9 : pn - 17) * 256;
#pragma unroll
            for (int ai = 0; ai < 2; ++ai)
#pragma unroll
                for (int m = 0; m < 4; ++m) { const int row = row0 + ai * 128 + m * 16;
#pragma unroll
                    for (int bj = 0; bj < 2; ++bj) { f32x4 v0 = acc[ai][bj][m][0], v1 = acc[ai][bj][m][1];
#pragma unroll
                        for (int e = 0; e < 4; ++e) { v0[e] = sigmoidf_(v0[e]); v1[e] = sigmoidf_(v1[e]); }
                        *(u32x4*)(G + (size_t)row * 2048 + pc + bj * 128 + ct0) = pack8(v0, v1); } }
        }
    }
};
__device__ __forceinline__ float rstd8(const float* st) { const f32x4 a = *(const f32x4*)st, b = *(const f32x4*)(st + 4); const float s = (a[0] + a[1]) + (a[2] + a[3]) + (b[0] + b[1]) + (b[2] + b[3]); return 1.0f / sqrtf(s * (1.0f / 512.0f) + EPS); }
struct EpiQ {
    bf16_t* Q; const float* STAT; const f32x2* ROPE;
    __device__ __forceinline__ void operator()(EPI_ARGS) const { EPI_ROWCOL
        const int pn = u.pn;
#pragma unroll
        for (int ai = 0; ai < 2; ++ai)
#pragma unroll
            for (int m = 0; m < 4; ++m) { const int row = row0 + ai * 128 + m * 16; const float rs = rstd8(STAT + (size_t)row * 32);
                if (pn < 8) {
#pragma unroll
                    for (int bj = 0; bj < 2; ++bj) *(u32x4*)(Q + (size_t)row * QW + (2 * pn + bj) * DQK + ct0) = pack8(acc[ai][bj][m][0] * rs, acc[ai][bj][m][1] * rs);
                } else { const int i0 = 16 * (wc & 1) + 4 * fq;
                    const f32x4 cs0 = *(const f32x4*)(ROPE + (size_t)row * 32 + i0), cs1 = *(const f32x4*)(ROPE + (size_t)row * 32 + i0 + 2);
#pragma unroll
                    for (int bj = 0; bj < 2; ++bj) { const int head = 4 * (pn - 8) + 2 * bj + (wc >> 1); const f32x4 v0 = acc[ai][bj][m][0] * rs, v1 = acc[ai][bj][m][1] * rs;
                        const float a0 = v0[0] * cs0[0] - v0[1] * cs0[1], b0 = v0[1] * cs0[0] + v0[0] * cs0[1];
                        const float a1 = v0[2] * cs0[2] - v0[3] * cs0[3], b1 = v0[3] * cs0[2] + v0[2] * cs0[3];
                        const float a2 = v1[0] * cs1[0] - v1[1] * cs1[1], b2 = v1[1] * cs1[0] + v1[0] * cs1[1];
                        const float a3 = v1[2] * cs1[2] - v1[3] * cs1[3], b3 = v1[3] * cs1[2] + v1[2] * cs1[3];
                        u32x2 wa, wb; wa.x = cvt_pk(a0, a1); wa.y = cvt_pk(a2, a3); wb.x = cvt_pk(b0, b1); wb.y = cvt_pk(b2, b3);
                        bf16_t* qp = Q + (size_t)row * QW + head * DQK + DN + i0; *(u32x2*)qp = wa; *(u32x2*)(qp + 32) = wb; } }
            }
    }
};
struct EpiKV {
    bf16_t* KV; const float* STAT;
    __device__ __forceinline__ void operator()(EPI_ARGS) const { EPI_ROWCOL
#pragma unroll
        for (int ai = 0; ai < 2; ++ai)
#pragma unroll
            for (int m = 0; m < 4; ++m) { const int row = row0 + ai * 128 + m * 16; const float rs = rstd8(STAT + (size_t)row * 32 + 8);
#pragma unroll
                for (int bj = 0; bj < 2; ++bj) *(u32x4*)(KV + (size_t)row * KVW + u.pn * 256 + bj * 128 + ct0) = pack8(acc[ai][bj][m][0] * rs, acc[ai][bj][m][1] * rs); }
    }
};
struct EpiMemKV {
    bf16_t *MEMK, *VMT;
    __device__ __forceinline__ void operator()(EPI_ARGS) const { EPI_ROWCOL
#pragma unroll
        for (int ai = 0; ai < 2; ++ai)
#pragma unroll
            for (int m = 0; m < 4; ++m) { const int row = row0 + ai * 128 + m * 16;
#pragma unroll
                for (int bj = 0; bj < 2; ++bj) { const u32x4 w = pack8(acc[ai][bj][m][0], acc[ai][bj][m][1]); const int col = u.pn * 256 + bj * 128 + ct0;
                    if (u.pn < 8) *(u32x4*)(MEMK + (size_t)row * 2048 + col) = w;
                    else { bf16_t* vp = VMT + (size_t)(col - 2048) * 256 + row;
                        vp[0 * 256] = (bf16_t)(w.x & 0xffff); vp[1 * 256] = (bf16_t)(w.x >> 16); vp[2 * 256] = (bf16_t)(w.y & 0xffff); vp[3 * 256] = (bf16_t)(w.y >> 16);
                        vp[4 * 256] = (bf16_t)(w.z & 0xffff); vp[5 * 256] = (bf16_t)(w.z >> 16); vp[6 * 256] = (bf16_t)(w.w & 0xffff); vp[7 * 256] = (bf16_t)(w.w >> 16); } } }
    }
};
template <int PASS> struct EpiMerge {
    bf16_t* T; const bf16_t* G;
    __device__ __forceinline__ void operator()(EPI_ARGS) const { EPI_ROWCOL
#pragma unroll
        for (int ai = 0; ai < 2; ++ai)
#pragma unroll
            for (int m = 0; m < 4; ++m) { const size_t ro = (size_t)(row0 + ai * 128 + m * 16) * 2048 + u.pn * 256 + ct0;
#pragma unroll
                for (int bj = 0; bj < 2; ++bj) { f32x4 g0, g1; unpack8(*(const u32x4*)(G + ro + bj * 128), g0, g1);
                    f32x4 v0 = acc[ai][bj][m][0] * g0, v1 = acc[ai][bj][m][1] * g1;
                    if (PASS == 1) { f32x4 t0, t1; unpack8(*(const u32x4*)(T + ro + bj * 128), t0, t1); v0 += t0; v1 += t1; }
                    *(u32x4*)(T + ro + bj * 128) = pack8(v0, v1); } }
    }
};
struct EpiF32Stat {
    bf16_t* O; float* STAT;
    __device__ __forceinline__ void operator()(EPI_ARGS) const { EPI_ROWCOL
#pragma unroll
        for (int ai = 0; ai < 2; ++ai)
#pragma unroll
            for (int m = 0; m < 4; ++m) { const int row = row0 + ai * 128 + m * 16; float s = 0.f;
#pragma unroll
                for (int bj = 0; bj < 2; ++bj) { const f32x4 v0 = acc[ai][bj][m][0], v1 = acc[ai][bj][m][1];
                    s += (v0[0] * v0[0] + v0[1] * v0[1]) + (v0[2] * v0[2] + v0[3] * v0[3]) + (v1[0] * v1[0] + v1[1] * v1[1]) + (v1[2] * v1[2] + v1[3] * v1[3]);
                    *(u32x4*)(O + (size_t)row * 2048 + u.pn * 256 + bj * 128 + ct0) = pack8(v0, v1); }
                s += __shfl_xor(s, 16); s += __shfl_xor(s, 32);
                if (fq == 0) STAT[(size_t)row * 32 + u.pn * 4 + wc] = s; }
    }
};
struct EpiSoftmax {
    bf16_t* PM; int coff; LAS f32x2* part;
    __device__ __forceinline__ void operator()(EPI_ARGS) const { EPI_ROWCOL
        constexpr float SC2 = 0.044194173824159216f * 1.4426950408889634f;
        float mloc[2][4];
#pragma unroll
        for (int ai = 0; ai < 2; ++ai)
#pragma unroll
            for (int m = 0; m < 4; ++m) { float mx = -3.0e38f;
#pragma unroll
                for (int bj = 0; bj < 2; ++bj)
#pragma unroll
                    for (int n = 0; n < 2; ++n)
#pragma unroll
                        for (int e = 0; e < 4; ++e) mx = fmaxf(mx, acc[ai][bj][m][n][e]);
                mx = fmaxf(mx, __shfl_xor(mx, 16)); mx = fmaxf(mx, __shfl_xor(mx, 32));
                float s = 0.f;
#pragma unroll
                for (int bj = 0; bj < 2; ++bj)
#pragma unroll
                    for (int n = 0; n < 2; ++n)
#pragma unroll
                        for (int e = 0; e < 4; ++e) s += __builtin_amdgcn_exp2f((acc[ai][bj][m][n][e] - mx) * SC2);
                s += __shfl_xor(s, 16); s += __shfl_xor(s, 32);
                mloc[ai][m] = mx;
                if (fq == 0) part[(ai * 128 + wr * 64 + m * 16 + fr) * 4 + wc] = (f32x2){mx, s}; }
        LDS_WAIT(); __builtin_amdgcn_s_barrier(); asm volatile("" ::: "memory");
#pragma unroll
        for (int ai = 0; ai < 2; ++ai)
#pragma unroll
            for (int m = 0; m < 4; ++m) { const int rl = ai * 128 + wr * 64 + m * 16 + fr;
                const f32x2 p0 = part[rl * 4 + 0], p1 = part[rl * 4 + 1], p2 = part[rl * 4 + 2], p3 = part[rl * 4 + 3];
                const float M = fmaxf(fmaxf(p0.x, p1.x), fmaxf(p2.x, p3.x));
                const float L = p0.y * __builtin_amdgcn_exp2f((p0.x - M) * SC2) + p1.y * __builtin_amdgcn_exp2f((p1.x - M) * SC2) + p2.y * __builtin_amdgcn_exp2f((p2.x - M) * SC2) + p3.y * __builtin_amdgcn_exp2f((p3.x - M) * SC2);
                const float inv = 1.0f / L;
                bf16_t* rp = PM + (size_t)(row0 + ai * 128 + m * 16) * 1024 + coff + ct0;
#pragma unroll
                for (int bj = 0; bj < 2; ++bj) { f32x4 v0 = acc[ai][bj][m][0], v1 = acc[ai][bj][m][1];
#pragma unroll
                    for (int e = 0; e < 4; ++e) { v0[e] = __builtin_amdgcn_exp2f((v0[e] - M) * SC2) * inv; v1[e] = __builtin_amdgcn_exp2f((v1[e] - M) * SC2) * inv; }
                    *(u32x4*)(rp + bj * 128) = pack8(v0, v1); } }
        LDS_WAIT(); __builtin_amdgcn_s_barrier(); asm volatile("" ::: "memory");
    }
};

__device__ __forceinline__ float gelu_tanh(float x) { const float y2 = 1.5957691216057308f * (x + 0.044715f * x * x * x); return x * __builtin_amdgcn_rcpf(1.f + __expf(-y2)); }

template <int CTRL> __device__ __forceinline__ float dppf(float old, float src) { return __int_as_float(__builtin_amdgcn_update_dpp(__float_as_int(old), __float_as_int(src), CTRL, 0xf, 0xf, false)); }
struct EpiFfn {
    bf16_t* ACTp; float* HALO; const float* conv_w; const float* conv_b; LAS float* xbuf;
    __device__ __forceinline__ void operator()(EPI_ARGS) const {
        const int rowb = u.pm * 256 + wr * 64 + 4 * fr; const int ct0 = wc * 32 + 8 * fq;
        const int ch0 = u.pn * 128 + ct0;
#pragma unroll
        for (int ai = 0; ai < 2; ++ai) if (fr == 15) {
#pragma unroll
            for (int bj = 0; bj < 2; ++bj)
#pragma unroll
                for (int n = 0; n < 2; ++n) { *(LAS f32x4*)(xbuf + ((2 * ai + wr) * 2 + 0) * 256 + bj * 128 + ct0 + 4 * n) = acc[ai][bj][2][n]; *(LAS f32x4*)(xbuf + ((2 * ai + wr) * 2 + 1) * 256 + bj * 128 + ct0 + 4 * n) = acc[ai][bj][3][n]; } }
        if (wr == 1 && fr == 15) {
#pragma unroll
            for (int bj = 0; bj < 2; ++bj)
#pragma unroll
                for (int n = 0; n < 2; ++n) { *(f32x4*)(HALO + ((size_t)u.pm * 4 + 2) * FF2 + u.pn * 256 + bj * 128 + ct0 + 4 * n) = acc[1][bj][2][n]; *(f32x4*)(HALO + ((size_t)u.pm * 4 + 3) * FF2 + u.pn * 256 + bj * 128 + ct0 + 4 * n) = acc[1][bj][3][n]; } }
        if (wr == 0 && fr == 0) {
#pragma unroll
            for (int bj = 0; bj < 2; ++bj)
#pragma unroll
                for (int n = 0; n < 2; ++n) { *(f32x4*)(HALO + ((size_t)u.pm * 4 + 0) * FF2 + u.pn * 256 + bj * 128 + ct0 + 4 * n) = acc[0][bj][0][n]; *(f32x4*)(HALO + ((size_t)u.pm * 4 + 1) * FF2 + u.pn * 256 + bj * 128 + ct0 + 4 * n) = acc[0][bj][1][n]; } }
        LDS_WAIT(); __builtin_amdgcn_s_barrier(); asm volatile("" ::: "memory");
#pragma unroll
        for (int n = 0; n < 2; ++n) {
            f32x4 wg[3], wu[3], bg, bu;
#pragma unroll
            for (int k = 0; k < 3; ++k) { wg[k] = *(const f32x4*)(conv_w + (size_t)k * FF2 + ch0 + 4 * n); wu[k] = *(const f32x4*)(conv_w + (size_t)k * FF2 + DFF + ch0 + 4 * n); }
            bg = *(const f32x4*)(conv_b + ch0 + 4 * n); bu = *(const f32x4*)(conv_b + DFF + ch0 + 4 * n);
#pragma unroll
            for (int ai = 0; ai < 2; ++ai) { const int c = 2 * ai + wr;
                f32x4 cv[2][4];
#pragma unroll
                for (int bj = 0; bj < 2; ++bj) { f32x4 h1 = (f32x4){0.f, 0.f, 0.f, 0.f}, h0 = h1;
                    if (c > 0) { h0 = *(const LAS f32x4*)(xbuf + ((c - 1) * 2 + 0) * 256 + bj * 128 + ct0 + 4 * n); h1 = *(const LAS f32x4*)(xbuf + ((c - 1) * 2 + 1) * 256 + bj * 128 + ct0 + 4 * n); }
                    const f32x4 x0 = acc[ai][bj][0][n], x1 = acc[ai][bj][1][n], x2 = acc[ai][bj][2][n], x3 = acc[ai][bj][3][n]; f32x4 s3, s2;
#pragma unroll
                    for (int e = 0; e < 4; ++e) { s3[e] = dppf<0x111>(h1[e], x3[e]); s2[e] = dppf<0x111>(h0[e], x2[e]); }
                    const f32x4 w0 = bj == 0 ? wg[0] : wu[0], w1 = bj == 0 ? wg[1] : wu[1], w2 = bj == 0 ? wg[2] : wu[2], bb = bj == 0 ? bg : bu;
                    cv[bj][0] = bb + w0 * s2 + w1 * s3 + w2 * x0;
                    cv[bj][1] = bb + w0 * s3 + w1 * x0 + w2 * x1;
                    cv[bj][2] = bb + w0 * x0 + w1 * x1 + w2 * x2;
                    cv[bj][3] = bb + w0 * x1 + w1 * x2 + w2 * x3; }
#pragma unroll
                for (int m = 0; m < 4; ++m) { f32x4 o;
#pragma unroll
                    for (int e = 0; e < 4; ++e) o[e] = gelu_tanh(cv[0][m][e]) * cv[1][m][e];
                    u32x2 w; w.x = cvt_pk(o[0], o[1]); w.y = cvt_pk(o[2], o[3]);
                    *(u32x2*)(ACTp + (size_t)(rowb + ai * 128 + m) * DFF + ch0 + 4 * n) = w; } } }
    }
};

namespace att {
constexpr int NW = 8, QBLK = 32, KVBLK = 64, QB = 256;
constexpr int SHM_V = 16384, SHM_K = 16384, SHM_R = 16384;
constexpr int NBUF = 3;
constexpr int LDS_BYTES = NBUF * (SHM_V + SHM_K + SHM_R) + NW * 64 * 4;
constexpr float SCALE = 0.07216878364870323f;
constexpr float THR = 8.f;
#define KSWZ(row, colB) ((row) * 256 + ((colB) ^ (((row) & 7) << 4)))
#define SBAR() __builtin_amdgcn_sched_barrier(0)
__device__ __forceinline__ int v_st(int k, int c) { const int kk = (k & ~0xC) | ((k & 4) << 1) | ((k & 8) >> 1); return ((kk >> 3) * 4 + (c >> 5)) * 512 + ((kk & 7) * 32 + (c & 31)) * 2; }
__device__ __forceinline__ int v_rd_base(int lane) { return ((lane & 3) << 3) | (((lane >> 2) & 3) << 6) | (((lane >> 4) & 1) << 5) | (((lane >> 5) & 1) << 8); }
constexpr int v_rd_off(int d0, int ks, int half) { return d0 * 512 + ks * 4096 + half * 2048; }
__device__ __forceinline__ int crow(int r, int hi) { return (r & 3) + 8 * (r >> 2) + 4 * hi; }
__device__ __forceinline__ bf16x8 load8(const bf16_t* p) { return *reinterpret_cast<const bf16x8*>(p); }
__device__ __forceinline__ void mask_tile(f32x16& p0, f32x16& p1, int dq) {
    const float NEG = -__builtin_inff();
#pragma unroll
    for (int r = 0; r < 16; ++r) { const int c = (r & 3) + 8 * (r >> 2); if (dq - c < 0) p0[r] = NEG; if (dq - c - 32 < 0) p1[r] = NEG; }
}
__device__ __forceinline__ void partialSM(f32x16& p0, f32x16& p1, float& m_reg, float& mn, float& alpha) {
    float pmax = p0[0];
#pragma unroll
    for (int r = 1; r < 16; ++r) pmax = fmaxf(pmax, p0[r]);
#pragma unroll
    for (int r = 0; r < 16; ++r) pmax = fmaxf(pmax, p1[r]);
    { auto rr = __builtin_amdgcn_permlane32_swap(__float_as_uint(pmax), __float_as_uint(pmax), false, false); pmax = fmaxf(__uint_as_float(rr[0]), __uint_as_float(rr[1])); }
    constexpr float C2 = 1.4426950408889634f * SCALE;
    if (__builtin_expect(__all((pmax - m_reg) * SCALE <= THR), 1)) { mn = m_reg; alpha = 1.f; }
    else { mn = fmaxf(m_reg, pmax); alpha = __builtin_amdgcn_exp2f((m_reg - mn) * C2); m_reg = mn; }
    const float mnL = -mn * C2;
#pragma unroll
    for (int r = 0; r < 16; ++r) p0[r] = fmaf(p0[r], C2, mnL);
#pragma unroll
    for (int r = 0; r < 16; ++r) p1[r] = fmaf(p1[r], C2, mnL);
#pragma unroll
    for (int r = 0; r < 16; ++r) p0[r] = __builtin_amdgcn_exp2f(p0[r]);
}
__device__ __forceinline__ void finishSM(f32x16& p0, f32x16& p1, float alpha, float& l_reg, bf16x8& pa0, bf16x8& pa1, bf16x8& pa2, bf16x8& pa3) {
#pragma unroll
    for (int r = 0; r < 16; ++r) p1[r] = __builtin_amdgcn_exp2f(p1[r]);
    float ps = 0;
#pragma unroll
    for (int r = 0; r < 16; ++r) ps += p0[r];
#pragma unroll
    for (int r = 0; r < 16; ++r) ps += p1[r];
    { auto rr = __builtin_amdgcn_permlane32_swap(__float_as_uint(ps), __float_as_uint(ps), false, false); ps = __uint_as_float(rr[0]) + __uint_as_float(rr[1]); }
    l_reg = l_reg * alpha + ps;
#define PK4(P, B_, OUT) do { unsigned a0 = cvt_pk(P[B_+0], P[B_+1]), a1 = cvt_pk(P[B_+2], P[B_+3]);                          \
        unsigned b0 = cvt_pk(P[B_+4], P[B_+5]), b1 = cvt_pk(P[B_+6], P[B_+7]);                                             \
        auto r0 = __builtin_amdgcn_permlane32_swap(a0, b0, false, false); auto r1 = __builtin_amdgcn_permlane32_swap(a1, b1, false, false); \
        u32x4 w = {r0[0], r1[0], r0[1], r1[1]}; OUT = *reinterpret_cast<bf16x8*>(&w); } while (0)
    PK4(p0, 0, pa0); PK4(p0, 8, pa1); PK4(p1, 0, pa2); PK4(p1, 8, pa3);
#undef PK4
}
__device__ __forceinline__ void qkt(f32x16& p0, f32x16& p1, const LAS char* Kb, int r32, int hi, const bf16x8* qr) {
    p0 = f32x16{}; p1 = f32x16{};
    const LAS char* kb[4];
#pragma unroll
    for (int dd = 0; dd < 4; ++dd) kb[dd] = Kb + KSWZ(r32, (dd * 16 + hi * 8) * 2);
#pragma unroll
    for (int d0 = 0; d0 < 12; ++d0) { const LAS char* a = kb[d0 & 3] + (d0 < 8 ? (d0 >> 2) * 128 : NBUF * SHM_K);
        if (d0 != 0 && (d0 & 1) == 0) SBAR();
        bf16x8 b0 = *reinterpret_cast<const LAS bf16x8*>(a);
        bf16x8 b1 = *reinterpret_cast<const LAS bf16x8*>(a + 32 * 256);
        p0 = __builtin_amdgcn_mfma_f32_32x32x16_bf16(b0, qr[d0], p0, 0, 0, 0);
        p1 = __builtin_amdgcn_mfma_f32_32x32x16_bf16(b1, qr[d0], p1, 0, 0, 0); }
}
__device__ __forceinline__ void pv_tile(f32x16* o, int vb0, bf16x8 pa0, bf16x8 pa1, bf16x8 pa2, bf16x8 pa3) {
#define TRRD(dst, off) asm volatile("ds_read_b64_tr_b16 %0, %1 offset:%2" : "=&v"(dst) : "v"(vb0), "i"(off) : "memory")
#define PV_D0(d0) do { s16x4 l0, l1, l2, l3, h0, h1, h2, h3; constexpr int b_ = v_rd_off(d0, 0, 0); \
        TRRD(l0, b_); TRRD(h0, b_ + 2048); TRRD(l1, b_ + 4096); TRRD(h1, b_ + 6144); TRRD(l2, b_ + 8192); TRRD(h2, b_ + 10240); TRRD(l3, b_ + 12288); TRRD(h3, b_ + 14336); \
        asm volatile("s_waitcnt lgkmcnt(0)" ::: "memory"); SBAR();   \
        o[d0] = __builtin_amdgcn_mfma_f32_32x32x16_bf16((bf16x8){l0[0], l0[1], l0[2], l0[3], h0[0], h0[1], h0[2], h0[3]}, pa0, o[d0], 0, 0, 0);   \
        o[d0] = __builtin_amdgcn_mfma_f32_32x32x16_bf16((bf16x8){l1[0], l1[1], l1[2], l1[3], h1[0], h1[1], h1[2], h1[3]}, pa1, o[d0], 0, 0, 0);   \
        o[d0] = __builtin_amdgcn_mfma_f32_32x32x16_bf16((bf16x8){l2[0], l2[1], l2[2], l2[3], h2[0], h2[1], h2[2], h2[3]}, pa2, o[d0], 0, 0, 0);   \
        o[d0] = __builtin_amdgcn_mfma_f32_32x32x16_bf16((bf16x8){l3[0], l3[1], l3[2], l3[3], h3[0], h3[1], h3[2], h3[3]}, pa3, o[d0], 0, 0, 0); } while (0)
    PV_D0(0); PV_D0(1); PV_D0(2); PV_D0(3);
#undef PV_D0
#undef TRRD
}
struct ARef { unsigned qoff, kvoff; bf16_t* O; int P0; int rev; };
struct Seam { bf16x8 qr[12]; int bt; };
struct Rsrc { __amdgpu_buffer_rsrc_t q, kv, r; };
__device__ __forceinline__ bf16x8 bload(__amdgpu_buffer_rsrc_t rs, unsigned voff, unsigned soff) { return __builtin_bit_cast(bf16x8, __builtin_amdgcn_raw_buffer_load_b128(rs, (int)voff, (int)soff, 0)); }
#define VMW() asm volatile("s_waitcnt vmcnt(0)" ::: "memory")
#define DMA_TILE(kvoff_, k0, bo) do { const int so_ = (int)((unsigned)(k0) * (KVW * 2) + (kvoff_)), sr2_ = (int)((unsigned)(k0) * (DR * 2));   \
        _Pragma("unroll") for (int j_ = 0; j_ < 2; ++j_) { const int pc_ = (bo) + (2 * wid + j_) * 1024;                                      \
            __builtin_amdgcn_raw_ptr_buffer_load_lds(RS.kv, (LAS void*)(K_lds + pc_), 16, voffK[j_], so_, 0, 0);                              \
            __builtin_amdgcn_raw_ptr_buffer_load_lds(RS.kv, (LAS void*)(V_lds + pc_), 16, voffV[j_], so_, 0, 0);                              \
            __builtin_amdgcn_raw_ptr_buffer_load_lds(RS.r, (LAS void*)(R_lds + pc_), 16, voffR[j_], sr2_, 0, 0); } } while (0)
#define DMA_OFFS int voffK[2], voffV[2], voffR[2];                                                                                             \
    _Pragma("unroll") for (int j_ = 0; j_ < 2; ++j_) { const int p_ = (2 * wid + j_) * 1024 + lane * 16;                                      \
        { const int row = p_ >> 8, pos = (p_ >> 4) & 15, lc = (pos & 8) | ((pos ^ row) & 7); voffK[j_] = row * (KVW * 2) + lc * 16; }            \
        { const int sub = p_ >> 9, kkh = sub >> 2, cblk = sub & 3, wi = p_ & 511, kkl = wi >> 6, cl = (wi & 63) >> 1, c = cblk * 32 + cl, kk = kkh * 8 + kkl, \
              k = (kk & ~0xC) | ((kk & 4) << 1) | ((kk & 8) >> 1); voffV[j_] = k * (KVW * 2) + (128 + c) * 2; }                                \
        { const int row = p_ >> 8, pos = (p_ >> 4) & 7, lc = (pos ^ row) & 7; voffR[j_] = row * (DR * 2) + lc * 16; } }
__device__ __forceinline__ void attn_prime(const ARef& cur, const Rsrc& RS, LAS char* lds, Seam& S) {
    const int tid = fresh_tid(), wid = __builtin_amdgcn_readfirstlane(tid >> 6), lane = tid & 63, r32 = lane & 31, hi = lane >> 5;
    const unsigned vq0 = (unsigned)((wid * QBLK + r32) * QW + hi * 8) * 2u;
    LAS char* V_lds = lds; LAS char* K_lds = lds + NBUF * SHM_V; LAS char* R_lds = lds + NBUF * (SHM_V + SHM_K);
    DMA_OFFS
#pragma unroll
    for (int d0 = 0; d0 < 12; ++d0) S.qr[d0] = bload(RS.q, vq0, cur.qoff + d0 * 32);
    DMA_TILE(cur.kvoff, (cur.rev ? (cur.P0 + QB) / KVBLK - 1 : 0) * KVBLK, 0); VMW(); S.bt = 0;
    __syncthreads();
}
__device__ __forceinline__ void attn_block(const ARef& cur, const ARef& nxt, const Rsrc& RS, LAS char* lds, Seam& S) {
    const int tid = fresh_tid(), wid = __builtin_amdgcn_readfirstlane(tid >> 6), lane = tid & 63, r32 = lane & 31, hi = lane >> 5;
    const int NT = (cur.P0 + QB) / KVBLK;
    const int qlo = cur.P0 + wid * QBLK, qm = qlo + r32 - 4 * hi;
    LAS char* V_lds = lds; LAS char* K_lds = lds + NBUF * SHM_V; LAS char* R_lds = lds + NBUF * (SHM_V + SHM_K);
    float m_reg = -1e30f, l_reg = 0; f32x16 o[4] = {};
    const unsigned vq0 = (unsigned)((wid * QBLK + r32) * QW + hi * 8) * 2u;
    DMA_OFFS
    const int vb0 = (int)(unsigned)(uintptr_t)V_lds + v_rd_base(lane);
    int bt = S.bt;
#define RESC(a) do { if (__any((a) < 1.f)) { _Pragma("unroll") for (int d_ = 0; d_ < 4; ++d_) o[d_] = o[d_] * (a); } } while (0)
#define MASKT(P0_, P1_, t) do { const int kb_ = (t) * KVBLK; if (kb_ + KVBLK - 1 > qlo) mask_tile(P0_, P1_, qm - kb_); } while (0)
#define TILE_OF(t) (rev ? NT - 1 - (t) : (t))
#define STAGE_NEXT(t, bo) do { if ((t) + 1 < NT) { DMA_TILE(cur.kvoff, TILE_OF((t) + 1) * KVBLK, bo); } else { DMA_TILE(nxt.kvoff, nxt_first * KVBLK, bo); } } while (0)
#define QNEXT(t) do { if ((t) + 1 >= NT) { _Pragma("unroll") for (int d0 = 0; d0 < 12; ++d0) S.qr[d0] = bload(RS.q, vq0, nxt.qoff + d0 * 32); } } while (0)
    const bool lag = wid >= 4;
    const int rev = cur.rev, nxt_first = nxt.rev ? (nxt.P0 + QB) / KVBLK - 1 : 0;
    f32x16 p0, p1; float mn, al; bf16x8 pa0, pa1, pa2, pa3;
#define STEP(t, FIRST) do { const int bn = bt == NBUF - 1 ? 0 : bt + 1, bp = bt == 0 ? NBUF - 1 : bt - 1;                              \
        SBAR(); STAGE_NEXT(t, bn * SHM_V); SBAR();                                                                           \
        if (lag && !(FIRST)) { pv_tile(o, vb0 + bp * SHM_V, pa0, pa1, pa2, pa3); SBAR(); }                                   \
        qkt(p0, p1, K_lds + bt * SHM_K, r32, hi, S.qr); SBAR();                                                             \
        QNEXT(t); SBAR();                                                                                                    \
        MASKT(p0, p1, TILE_OF(t)); partialSM(p0, p1, m_reg, mn, al); if (!(FIRST)) RESC(al);                               \
        finishSM(p0, p1, al, l_reg, pa0, pa1, pa2, pa3); SBAR();                                                             \
        if (!lag) { pv_tile(o, vb0 + bt * SHM_V, pa0, pa1, pa2, pa3); SBAR(); }                                              \
        VMW(); __syncthreads(); bt = bn; } while (0)
    STEP(0, true);
#pragma unroll 1
    for (int t = 1; t < NT; ++t) STEP(t, false);
    if (lag) { const int bp = bt == 0 ? NBUF - 1 : bt - 1; pv_tile(o, vb0 + bp * SHM_V, pa0, pa1, pa2, pa3); SBAR(); }
#undef STEP
    S.bt = bt;
    {
        const float inv = __builtin_amdgcn_rcpf(l_reg);
        bf16_t* Orow = cur.O + (size_t)(wid * QBLK + r32) * DM + (hi ? 8 : 0);
#pragma unroll
        for (int d0 = 0; d0 < 4; ++d0)
#pragma unroll
            for (int gp = 0; gp < 2; ++gp) { const int ra = 8 * gp, rb = 8 * gp + 4;
                unsigned ax = cvt_pk(o[d0][ra] * inv, o[d0][ra + 1] * inv), ay = cvt_pk(o[d0][ra + 2] * inv, o[d0][ra + 3] * inv);
                unsigned bx = cvt_pk(o[d0][rb] * inv, o[d0][rb + 1] * inv), by = cvt_pk(o[d0][rb + 2] * inv, o[d0][rb + 3] * inv);
                auto sx = __builtin_amdgcn_permlane32_swap(ax, bx, false, false); auto sy = __builtin_amdgcn_permlane32_swap(ay, by, false, false);
                u32x4 w = {sx[0], sy[0], sx[1], sy[1]};
                *(u32x4*)(Orow + d0 * 32 + 16 * gp) = w; }
    }
#undef RESC
#undef MASKT
#undef STAGE_NEXT
#undef TILE_OF
#undef QNEXT
}
#undef VMW
__device__ __forceinline__ ARef make_ref(int L, int pass, bf16_t* O) {
    const int h = L >> 5, x = L & 31, qb = pass ? x : 63 - x;
    ARef r; r.qoff = (unsigned)(qb * QB * QW + h * DQK) * 2u; r.kvoff = (unsigned)(h * 256) * 2u; r.O = O + (size_t)qb * QB * DM + h * DV; r.P0 = qb * QB; r.rev = pass;
    return r;
}
__device__ __forceinline__ void attn_phase(LAS char* lds, const bf16_t* Q, const bf16_t* KV, const bf16_t* KPE, bf16_t* O, int vcu, int G) {
    constexpr int TOTAL = 512;
    int L = vcu; if (L >= TOTAL) return;
    int pass = 0;
    Rsrc RS; RS.q = __builtin_amdgcn_make_buffer_rsrc((void*)Q, 0, 0x7fffffff, 0x00020000); RS.kv = __builtin_amdgcn_make_buffer_rsrc((void*)KV, 0, 0x7fffffff, 0x00020000); RS.r = __builtin_amdgcn_make_buffer_rsrc((void*)KPE, 0, 0x7fffffff, 0x00020000);
    ARef cur = make_ref(L, 0, O);
    Seam S;
    if (__builtin_amdgcn_readfirstlane((int)threadIdx.x >> 6) < 4) __builtin_amdgcn_s_setprio(2); else __builtin_amdgcn_s_setprio(0);
    attn_prime(cur, RS, lds, S);
    for (;;) {
        const bool more_pass = pass == 0, more_item = L + G < TOTAL, last = !more_pass && !more_item;
        int passn = pass + 1, Ln = L;
        if (!more_pass) { passn = 0; Ln = more_item ? L + G : L; }
        const ARef nxt = last ? cur : make_ref(Ln, passn, O);
        attn_block(cur, nxt, RS, lds, S);
        if (last) { __builtin_amdgcn_s_setprio(0); break; }
        cur = nxt; pass = passn; L = Ln;
    }
}
#undef KSWZ
#undef SBAR
}

struct Args { const void* in[27]; float* out; unsigned char* ws; float inv_freq[32]; };

template <class Map>
__device__ __forceinline__ void transpose_item(const float* W, int K, int N, bf16_t* WT, int nblk, LAS float* scr, int item, int lane, Map map, const float* kscale, const float* nscale) {
    const int kb = item / nblk, nb = item % nblk, k0 = 64 * kb, n0 = 32 * nb;
    const int src = map(n0 + (lane & 31));
    const float ns = (src >= 0 && nscale) ? nscale[src] : 1.f;
    const int src0 = map(n0);
    if (src0 >= 0 && (src0 & 3) == 0 && (N & 3) == 0 && __all(src == src0 + (lane & 31)) && !nscale) {
        const int kr = lane >> 3, nq = lane & 7;
#pragma unroll
        for (int i = 0; i < 8; ++i) { const int kk = 8 * i + kr; f32x4 v = __builtin_nontemporal_load((const f32x4*)(W + (size_t)(k0 + kk) * N + src0 + 4 * nq)); if (kscale) v = v * kscale[k0 + kk];
            LAS float* d = scr + kk * 33 + 4 * nq; d[0] = v[0]; d[1] = v[1]; d[2] = v[2]; d[3] = v[3]; }
    } else {
#pragma unroll 8
    for (int i = 0; i < 32; ++i) { const int kk = 2 * i + (lane >> 5); float v = src >= 0 ? __builtin_nontemporal_load(&W[(size_t)(k0 + kk) * N + src]) : 0.f;     v *= ns; if (kscale) v *= kscale[k0 + kk]; scr[kk * 33 + (lane & 31)] = v; }
    }
    LDS_WAIT(); asm volatile("" ::: "memory");
    const int c = lane & 7;
#pragma unroll
    for (int j = 0; j < 4; ++j) { const int n = (lane >> 3) + 8 * j; const LAS float* s = scr + (8 * c) * 33 + n;
        u32x4 o; o.x = cvt_pk(s[0 * 33], s[1 * 33]); o.y = cvt_pk(s[2 * 33], s[3 * 33]); o.z = cvt_pk(s[4 * 33], s[5 * 33]); o.w = cvt_pk(s[6 * 33], s[7 * 33]);
        *(u32x4*)(WT + (size_t)(n0 + n) * K + k0 + 8 * c) = o; }
    LDS_WAIT(); asm volatile("" ::: "memory");
}
struct MapId { __device__ __forceinline__ int operator()(int n) const { return n; } };
struct MapIn { __device__ __forceinline__ int operator()(int n) const { if (n < 1024) return n; if (n < 1280) { const int j = n - 1024; if (j >= 64) return -1; return 1024 + ((j & 1) ? 32 + (j >> 1) : (j >> 1)); } return n - 1280 + 1088; } };
struct MapQ { __device__ __forceinline__ int operator()(int n) const { if (n < 2048) return (n >> 7) * DQK + (n & 127); const int j = n - 2048, head = j >> 6, jj = j & 63, i = jj >> 1; return head * DQK + DN + ((jj & 1) ? i + 32 : i); } };
struct MapFfn { __device__ __forceinline__ int operator()(int n) const { const int tile = n >> 8, r = n & 255, ch = 128 * tile + (r & 127); return r < 128 ? ch : DFF + ch; } };

__device__ __forceinline__ void rms_row_bf16(const float* xrow, const float* g, bf16_t* orow, int lane) {
    f32x4 v[8]; float s = 0.f;
#pragma unroll
    for (int j = 0; j < 8; ++j) { v[j] = *(const f32x4*)(xrow + 4 * lane + 256 * j); s += (v[j][0] * v[j][0] + v[j][1] * v[j][1]) + (v[j][2] * v[j][2] + v[j][3] * v[j][3]); }
    const float rstd = 1.0f / sqrtf(wave_sum(s) * (1.0f / DM) + EPS);
#pragma unroll
    for (int j = 0; j < 8; ++j) { const f32x4 gg = *(const f32x4*)(g + 4 * lane + 256 * j); const f32x4 y = v[j] * rstd * gg;
        u32x2 w; w.x = cvt_pk(y[0], y[1]); w.y = cvt_pk(y[2], y[3]); *(u32x2*)(orow + 4 * lane + 256 * j) = w; }
}
template <bool SECOND>
__device__ __forceinline__ void resid_row(const float* xi, const bf16_t* mo, const float* stat, const float* gpost, float* xo, const float* gpre, bf16_t* hrow, int lane) {
    const float st = stat[lane & 31]; float ss = st;
#pragma unroll
    for (int o = 1; o < 32; o <<= 1) ss += __shfl_xor(ss, o);
    const float rstd = 1.0f / sqrtf(ss * (1.0f / DM) + EPS);
    f32x4 v[8]; float s = 0.f;
#pragma unroll
    for (int j = 0; j < 8; ++j) { const int c = 4 * lane + 256 * j; const u32x2 mw = __builtin_nontemporal_load((const u32x2*)(mo + c)); const f32x4 a = __builtin_nontemporal_load((const f32x4*)(xi + c)),     b = (f32x4){bf_lo(mw.x), bf_hi(mw.x), bf_lo(mw.y), bf_hi(mw.y)}, gg = *(const f32x4*)(gpost + c);
        v[j] = a + b * rstd * gg; s += (v[j][0] * v[j][0] + v[j][1] * v[j][1]) + (v[j][2] * v[j][2] + v[j][3] * v[j][3]); *(f32x4*)(xo + c) = v[j]; }
    if (SECOND) { const float r2 = 1.0f / sqrtf(wave_sum(s) * (1.0f / DM) + EPS);
#pragma unroll
        for (int j = 0; j < 8; ++j) { const int c = 4 * lane + 256 * j; const f32x4 gg = *(const f32x4*)(gpre + c); const f32x4 y = v[j] * r2 * gg;
            u32x2 w; w.x = cvt_pk(y[0], y[1]); w.y = cvt_pk(y[2], y[3]); *(u32x2*)(hrow + c) = w; } }
}

#define W_IN ((bf16_t*)(ws + WS_W_IN))
#define W_QB ((bf16_t*)(ws + WS_W_QB))
#define W_KVB ((bf16_t*)(ws + WS_W_KVB))
#define W_ATT ((bf16_t*)(ws + WS_W_ATT))
#define W_PG ((bf16_t*)(ws + WS_W_PG))
#define W_PBR ((bf16_t*)(ws + WS_W_PBR))
#define W_MIX ((bf16_t*)(ws + WS_W_MIX))
#define W_MQ ((bf16_t*)(ws + WS_W_MQ))
#define W_MKV ((bf16_t*)(ws + WS_W_MKV))
#define W_MO ((bf16_t*)(ws + WS_W_MO))
#define W_FIN ((bf16_t*)(ws + WS_W_FIN))
#define W_FOUT ((bf16_t*)(ws + WS_W_FOUT))
#define ROPE ((f32x2*)(ws + WS_ROPE))
#define STAT ((float*)(ws + WS_STAT))
#define KPE ((bf16_t*)(ws + WS_KPE))
#define MEMN ((bf16_t*)(ws + WS_MEMN))
#define MEMKV ((bf16_t*)(ws + WS_MEMK))
#define WKT ((bf16_t*)(ws + 452 * MiB))
#define VWT ((bf16_t*)(ws + 448 * MiB))
#define H3 ((bf16_t*)(ws + WS_H3))
#define QC ((bf16_t*)(ws + WS_QC))
#define U ((bf16_t*)(ws + WS_U))
#define GA ((bf16_t*)(ws + WS_GA))
#define GP ((bf16_t*)(ws + WS_GP))
#define D ((bf16_t*)(dob + DO_PD))
#define W_PCT ((bf16_t*)(ws + 4 * MiB))
#define KV ((bf16_t*)(ws + WS_KV))
#define AO ((bf16_t*)(ws + WS_AO))
#define MERGED ((bf16_t*)(ws + WS_MERGED))
#define MO ((bf16_t*)(ws + WS_MO))
#define H2 ((bf16_t*)(ws + WS_H2))
#define QM ((bf16_t*)(ws + WS_QM))
#define PM ((bf16_t*)(ws + WS_PM))
#define OM ((bf16_t*)(ws + WS_OM))
#define MO2 ((bf16_t*)(ws + WS_MO2))
#define AH ((bf16_t*)(ws + WS_AH))
#define ACT ((bf16_t*)(ws + WS_ACT))
#define MO3 ((bf16_t*)(ws + WS_MO3))
#define H ((bf16_t*)(dob + DO_H))
#define Q ((bf16_t*)(dob + DO_Q))


#define XB_TMO      128
#define XB_XCNT(j)  (256  + 64 * (j))
#define XB_XSUB(j)  (1280 + 64 * (j))
#define XB_XGEN(j)  (2304 + 64 * (j))
#define XB_TOP      3328
#define XB_TOPGEN   3392
#define XCD_BAR_WORDS 3456
#define XB_SPIN_CAP (1u << 20)
__device__ unsigned g_bar[XCD_BAR_WORDS];
__device__ __forceinline__ unsigned xb_ld(unsigned* p)              { return __hip_atomic_load(p, __ATOMIC_RELAXED, __HIP_MEMORY_SCOPE_AGENT); }
__device__ __forceinline__ unsigned xb_add(unsigned* p, unsigned v) { return __hip_atomic_fetch_add(p, v, __ATOMIC_RELAXED, __HIP_MEMORY_SCOPE_AGENT); }
__device__ __forceinline__ unsigned xb_xcc_id() { return (unsigned)__builtin_amdgcn_s_getreg((3 << 11) | 20) & 0xFu; }
#define XB_SPIN(cond, bar) do { unsigned _sp = 0; while (cond) { __builtin_amdgcn_s_sleep(1); \
    if ((++_sp & 255u) == 0u) { if (xb_ld(&(bar)[XB_TMO])) break; if (_sp > XB_SPIN_CAP) { atomicAdd(&(bar)[XB_TMO], 1u); break; } } } } while (0)
struct XcdBarrier { unsigned* bar; unsigned x; volatile LAS unsigned* st; };
__device__ __forceinline__ XcdBarrier xcd_barrier_post(unsigned* bar, volatile LAS unsigned* st) {
    XcdBarrier b; b.bar = bar; b.x = xb_xcc_id(); b.st = st;
    if (threadIdx.x == 0) (void)xb_add(&bar[XB_XCNT(b.x)], 1u);
    return b;
}
__device__ __forceinline__ void xcd_barrier_complete(unsigned* bar, unsigned x, unsigned& nloc, unsigned& nx) {
    const unsigned G = gridDim.x * gridDim.y * gridDim.z;
    unsigned sum, cnt, mine, sp = 0u;
    for (;;) {
        sum = 0u; cnt = 0u; mine = 0u;
#pragma unroll
        for (unsigned j = 0; j < 16; ++j) { const unsigned c = xb_ld(&bar[XB_XCNT(j)]); sum += c; cnt += (c > 0u) ? 1u : 0u; mine = (j == x) ? c : mine; }
        if (sum == G) break;
        __builtin_amdgcn_s_sleep(1);
        if ((++sp & 255u) == 0u) { if (xb_ld(&bar[XB_TMO])) break; if (sp > XB_SPIN_CAP) { atomicAdd(&bar[XB_TMO], 1u); break; } }
    }
    nloc = mine > 0u ? mine : 1u; nx = cnt > 0u ? cnt : 1u;
}
__device__ __forceinline__ void xcd_barrier(const XcdBarrier& b) {
    asm volatile("s_waitcnt vmcnt(0)" ::: "memory");
    __syncthreads();
    if (threadIdx.x == 0) {
        unsigned* bar = b.bar;
        __builtin_amdgcn_s_waitcnt(0);
        unsigned nloc = b.st[0], nx = b.st[1];
        if (nloc == 0u) { xcd_barrier_complete(bar, b.x, nloc, nx); b.st[0] = nloc; b.st[1] = nx; }
        const unsigned old = xb_add(&bar[XB_XSUB(b.x)], 1u);
        const unsigned gen = old / nloc;
        if (old + 1u == (gen + 1u) * nloc) {
            __builtin_amdgcn_fence(__ATOMIC_RELEASE, "agent");
            asm volatile("s_waitcnt vmcnt(0)" ::: "memory");
            const unsigned og = xb_add(&bar[XB_TOP], 1u);
            const unsigned tg = og / nx;
            if (og + 1u == (tg + 1u) * nx) xb_add(&bar[XB_TOPGEN], 1u);
            else XB_SPIN(xb_ld(&bar[XB_TOPGEN]) == tg, bar);
            __builtin_amdgcn_fence(__ATOMIC_ACQUIRE, "agent");
            xb_add(&bar[XB_XGEN(b.x)], 1u);
            asm volatile("s_waitcnt vmcnt(0)" ::: "memory");
        } else {
            XB_SPIN(xb_ld(&bar[XB_XGEN(b.x)]) == gen, bar);
            __builtin_amdgcn_fence(__ATOMIC_ACQUIRE, "agent");
            asm volatile("s_waitcnt vmcnt(0)" ::: "memory");
        }
    }
    __syncthreads();
}
__global__ void __launch_bounds__(NTHREADS) fwd_megakernel(Args a) {
    extern __shared__ __attribute__((aligned(16))) unsigned char lds_raw[];
    cg::grid_group grid = cg::this_grid();
    LAS unsigned char* lds = (LAS unsigned char*)lds_raw;
    const int G = gridDim.x, bid = blockIdx.x;
    if (bid == 0) for (int u_ = threadIdx.x; u_ < XCD_BAR_WORDS; u_ += NTHREADS) g_bar[u_] = 0u;
    volatile LAS unsigned* bar_st = (volatile LAS unsigned*)(lds + (152 * 1024 - 64));
    if (threadIdx.x < 2) bar_st[threadIdx.x] = 0u;
    __syncthreads();
    const int vcu = (G % 8 == 0) ? (bid % 8) * (G / 8) + bid / 8 : bid;
    const int NGW = G * NWAVES, NGT = G * NTHREADS;
#define PHASE_IDS const int tid = fresh_tid(), lane = tid & 63, wave = __builtin_amdgcn_readfirstlane(tid >> 6), gw = bid * NWAVES + wave, gt = bid * NTHREADS + tid; (void)lane; (void)gw; (void)gt;
    unsigned char* ws = a.ws; unsigned char* dob = (unsigned char*)a.out;
    const float* x = (const float*)a.in[0];
#ifndef ATT_ONLY
    {
        PHASE_IDS
        LAS float* scr = (LAS float*)(lds + wave * 8704);
        const float* w_in = (const float*)a.in[4]; const float* g_q_a = (const float*)a.in[5]; const float* w_q_b = (const float*)a.in[6]; const float* g_kv_a = (const float*)a.in[7];
        const float* w_kv_b = (const float*)a.in[8]; const float* w_attn_br = (const float*)a.in[9]; const float* w_pool_grp = (const float*)a.in[10]; const float* pool_scale = (const float*)a.in[11];
        const float* w_pool_br = (const float*)a.in[12]; const float* w_mix_out = (const float*)a.in[13]; const float* w_mem_q = (const float*)a.in[17]; const float* w_mem_kv = (const float*)a.in[18];
        const float* w_mem_o = (const float*)a.in[19]; const float* w_ffn_in = (const float*)a.in[22]; const float* w_ffn_out = (const float*)a.in[25];
        constexpr int I_IN = 32 * (DINP / 32), I_QB = 8 * (QW / 32), I_KVB = 8 * (KVW / 32), I_SQ = 32 * 64, I_PG = 256, I_PBR = 16 * 64, I_MKV = 32 * 128, I_FIN = 32 * (FF2 / 32), I_FOUT = 88 * 64;
        constexpr int NITEMS = I_IN + I_QB + I_KVB + I_SQ + 4 * I_PG + I_PBR + I_SQ + I_SQ + I_MKV + I_SQ + I_FIN + I_FOUT;
        for (int it = gw; it < NITEMS; it += NGW) {
            int r = it;
            if (r < I_IN) { transpose_item(w_in, DM, DIN, W_IN, DINP / 32, scr, r, lane, MapIn(), nullptr, nullptr); continue; } r -= I_IN;
            if (r < I_QB) { transpose_item(w_q_b, QL, QW, W_QB, QW / 32, scr, r, lane, MapQ(), g_q_a, nullptr); continue; } r -= I_QB;
            if (r < I_KVB) { transpose_item(w_kv_b, QL, KVW, W_KVB, KVW / 32, scr, r, lane, MapId(), g_kv_a, nullptr); continue; } r -= I_KVB;
            if (r < I_SQ) { transpose_item(w_attn_br, DM, DM, W_ATT, 64, scr, r, lane, MapId(), nullptr, nullptr); continue; } r -= I_SQ;
            if (r < 4 * I_PG) {
                const f32x4 v = *(const f32x4*)(w_pool_grp + (size_t)r * 256 + 4 * lane) * *(const f32x4*)(pool_scale + (r >> 8) * 256 + 4 * lane);
                u32x2 w; w.x = cvt_pk(v[0], v[1]); w.y = cvt_pk(v[2], v[3]); *(u32x2*)(W_PG + (size_t)r * 256 + 4 * lane) = w; continue; } r -= 4 * I_PG;
            if (r < I_PBR) { transpose_item(w_pool_br, PW, DM, W_PBR, 64, scr, r, lane, MapId(), nullptr, nullptr); continue; } r -= I_PBR;
            if (r < I_SQ) { transpose_item(w_mix_out, DM, DM, W_MIX, 64, scr, r, lane, MapId(), nullptr, nullptr); continue; } r -= I_SQ;
            if (r < I_SQ) {
#pragma unroll
                for (int j = 0; j < 8; ++j) { const f32x4 v = __builtin_nontemporal_load((const f32x4*)(w_mem_q + (size_t)r * DM + 4 * lane + 256 * j)); u32x2 w; w.x = cvt_pk(v[0], v[1]); w.y = cvt_pk(v[2], v[3]); *(u32x2*)(W_MQ + (size_t)r * DM + 4 * lane + 256 * j) = w; }
                continue; } r -= I_SQ;
            if (r < I_MKV) { transpose_item(w_mem_kv, DM, 4096, W_MKV, 128, scr, r, lane, MapId(), nullptr, nullptr); continue; } r -= I_MKV;
            if (r < I_SQ) { transpose_item(w_mem_o, DM, DM, W_MO, 64, scr, r, lane, MapId(), nullptr, nullptr); continue; } r -= I_SQ;
            if (r < I_FIN) { transpose_item(w_ffn_in, DM, FF2, W_FIN, FF2 / 32, scr, r, lane, MapFfn(), nullptr, nullptr); continue; } r -= I_FIN;
            transpose_item(w_ffn_out, DFF, DM, W_FOUT, 64, scr, r, lane, MapId(), nullptr, nullptr);
        }
        const float* g_mix_pre = (const float*)a.in[3]; const float* mem = (const float*)a.in[1]; const float* g_mem_kv = (const float*)a.in[16];
        for (int m = gw; m < S_; m += NGW) rms_row_bf16(x + (size_t)m * DM, g_mix_pre, H + (size_t)m * DM, lane);
        for (int m = gw; m < NMEM; m += NGW) rms_row_bf16(mem + (size_t)m * DM, g_mem_kv, MEMN + (size_t)m * DM, lane);
        const int* pos = (const int*)a.in[2];
        for (int e = gt; e < S_ * 32; e += NGT) { const int row = e >> 5, i = e & 31; const float ang = (float)pos[row] * a.inv_freq[i];
            double rev = (double)ang * 0.15915494309189535; rev -= floor(rev); const float rf = (float)rev;
            ROPE[e] = (f32x2){__builtin_amdgcn_cosf(rf), __builtin_amdgcn_sinf(rf)}; }
    }
    grid.sync();
    const XcdBarrier xbar = xcd_barrier_post(g_bar, bar_st);

    { pg8::Gemm g{H, W_IN, DM, DM, DM}; pg8::Order S; S.init(64, 25, G, bid, 0); EpiIn E{QC, U, GA, GP, KPE, STAT, ROPE}; pg8::gemm_phase<EpiIn, false, true>(lds, g, S, E); }
    xcd_barrier(xbar);

    {
        PHASE_IDS
        for (int it = gt; it < 128 * 1024; it += NGT) { const int cgp = it & 127, chunk = it >> 7, t0 = chunk * 16, c = cgp * 8, w = 2 << (cgp >> 5);
            float sum[8];
#pragma unroll
            for (int e = 0; e < 8; ++e) sum[e] = 0.f;
            for (int k = 1; k < w; ++k) { const int t = t0 - k; if (t >= 0) { f32x4 p, q; unpack8(*(const u32x4*)(U + (size_t)t * PW + c), p, q);
#pragma unroll
                for (int e = 0; e < 4; ++e) { sum[e] += p[e]; sum[4 + e] += q[e]; } } }
            for (int r = 0; r < 16; ++r) { const int t = t0 + r; f32x4 p, q; unpack8(*(const u32x4*)(U + (size_t)t * PW + c), p, q);
#pragma unroll
                for (int e = 0; e < 4; ++e) { sum[e] += p[e]; sum[4 + e] += q[e]; }
                const float ic = 1.0f / (float)(t + 1 < w ? t + 1 : w); f32x4 d0, d1;
#pragma unroll
                for (int e = 0; e < 4; ++e) { d0[e] = sum[e] * ic - p[e]; d1[e] = sum[4 + e] * ic - q[e]; }
                *(u32x4*)(D + (size_t)t * PW + c) = pack8(d0, d1);
                const int tt = t - w + 1; if (tt >= 0) { f32x4 p2, q2; unpack8(*(const u32x4*)(U + (size_t)tt * PW + c), p2, q2);
#pragma unroll
                    for (int e = 0; e < 4; ++e) { sum[e] -= p2[e]; sum[4 + e] -= q2[e]; } } } }
        { pg8::Gemm g{QC, W_QB, 1024, QL, QL}; pg8::Order S; S.init(64, 12, G, bid, 0); EpiQ E{Q, STAT, ROPE}; pg8::gemm_phase(lds, g, S, E); }
        { pg8::Gemm g{QC + 512, W_KVB, 1024, QL, QL}; pg8::Order S; S.init(64, 16, G, bid, 0); EpiKV E{KV, STAT}; pg8::gemm_phase(lds, g, S, E); }
        { pg8::Gemm g{MEMN, W_MKV, DM, DM, DM}; pg8::Order S; S.init(1, 16, G, bid, 0); EpiStore E{MEMKV, 4096, 0}; pg8::gemm_phase(lds, g, S, E); }
#pragma unroll 1
        for (int gi = 0; gi < 4; ++gi) { pg8::Gemm g{W_PBR + gi * 256, W_PG + gi * 65536, PW, 256, 256}; pg8::Order S; S.init(8, 1, G, bid, 16 + gi * 8); EpiStore E{W_PCT, PW, gi * 256}; pg8::gemm_phase(lds, g, S, E); }
    }
    xcd_barrier(xbar);

#endif
    {
#ifndef ATT_ONLY
#endif
#ifndef NO_ATT
        att::attn_phase((LAS char*)lds, Q, KV, KPE, AO, vcu, G);
#endif
    }
    xcd_barrier(xbar);

#ifndef ATT_ONLY
    { pg8::Gemm g{AO, W_ATT, DM, DM, DM}; pg8::Order S; S.init(64, 8, G, bid, 0); EpiMerge<0> E{MERGED, GA}; pg8::gemm_phase(lds, g, S, E); }
    { pg8::Gemm g{D, W_PCT, PW, PW, PW}; pg8::Order S; S.init(64, 8, G, bid, 0); EpiMerge<1> E{MERGED, GP}; pg8::gemm_phase(lds, g, S, E); }
    xcd_barrier(xbar);

    { pg8::Gemm g{MERGED, W_MIX, DM, DM, DM}; pg8::Order S; S.init(64, 8, G, bid, 0); EpiF32Stat E{MO, STAT}; pg8::gemm_phase(lds, g, S, E); }
    xcd_barrier(xbar);

#pragma unroll 1
    for (int h = 0; h < 4; ++h) { pg8::Gemm g{W_MO + h * MHD, MEMKV + 2048 + h * MHD, DM, 4096, MHD}; pg8::Order S; S.init(8, 1, G, bid, h * 8); EpiStore E{VWT, 1024, h * 256}; pg8::gemm_phase(lds, g, S, E); }
#pragma unroll 1
    for (int h = 0; h < 4; ++h) { pg8::Gemm g{MEMKV + h * MHD, W_MQ + h * MHD, 4096, DM, MHD}; pg8::Order S; S.init(1, 8, G, bid, 32 + h * 8); EpiStore E{WKT + (size_t)h * 256 * DM, DM, 0}; pg8::gemm_phase(lds, g, S, E); }
    { PHASE_IDS for (int m = gw; m < S_; m += NGW) resid_row<true>(x + (size_t)m * DM, MO + (size_t)m * DM, STAT + (size_t)m * 32, (const float*)a.in[14], a.out + (size_t)m * DM, (const float*)a.in[15], H2 + (size_t)m * DM, lane); }
    xcd_barrier(xbar);

#pragma unroll 1
    for (int h = 0; h < 4; ++h) { pg8::Gemm g{H2, WKT + (size_t)h * 256 * DM, DM, DM, DM}; pg8::Order S; S.init(64, 1, G, bid, h * 64); EpiSoftmax E{PM, h * 256, (LAS f32x2*)(lds + pg8::STAGE_BYTES)}; pg8::gemm_phase(lds, g, S, E); }
    xcd_barrier(xbar);

    { pg8::Gemm g{PM, VWT, 1024, 1024, 1024}; pg8::Order S; S.init(64, 8, G, bid, 0); EpiF32Stat E{MO2, STAT}; pg8::gemm_phase(lds, g, S, E); }
    xcd_barrier(xbar);

    { PHASE_IDS for (int m = gw; m < S_; m += NGW) resid_row<true>(a.out + (size_t)m * DM, MO2 + (size_t)m * DM, STAT + (size_t)m * 32, (const float*)a.in[20], a.out + (size_t)m * DM, (const float*)a.in[21], H3 + (size_t)m * DM, lane); }
    xcd_barrier(xbar);

    { pg8::Gemm g{H3, W_FIN, DM, DM, DM}; pg8::Order S; S.init(64, 44, G, bid, 0); EpiFfn E{ACT, (float*)(ws + WS_AH), (const float*)a.in[23], (const float*)a.in[24], (LAS float*)(lds + pg8::STAGE_BYTES)}; pg8::gemm_phase<EpiFfn, true>(lds, g, S, E); }
    xcd_barrier(xbar);
    {
        PHASE_IDS
        const float* conv_w = (const float*)a.in[23]; const float* conv_b = (const float*)a.in[24]; const float* HALO = (const float*)(ws + WS_AH);
        for (int it = gt; it < 63 * 2 * 704; it += NGT) { const int cg8 = it % 704, rr = (it / 704) & 1, pm = 1 + it / 1408, tile = cg8 >> 4, c = (cg8 & 15) * 8, ch = tile * 128 + c, gcol = tile * 256 + c;
            const float* r0 = HALO + ((size_t)pm * 4 + rr) * FF2; const float* r1 = rr ? HALO + ((size_t)pm * 4 + 0) * FF2 : HALO + ((size_t)(pm - 1) * 4 + 3) * FF2; const float* r2 = rr ? HALO + ((size_t)(pm - 1) * 4 + 3) * FF2 : HALO + ((size_t)(pm - 1) * 4 + 2) * FF2;
            f32x4 o[2];
#pragma unroll
            for (int q = 0; q < 2; ++q) { const int cc = gcol + 4 * q, jj = ch + 4 * q;
                const f32x4 cgv = *(const f32x4*)(conv_b + jj) + *(const f32x4*)(conv_w + jj) * *(const f32x4*)(r2 + cc) + *(const f32x4*)(conv_w + FF2 + jj) * *(const f32x4*)(r1 + cc) + *(const f32x4*)(conv_w + 2 * (size_t)FF2 + jj) * *(const f32x4*)(r0 + cc);
                const f32x4 cuv = *(const f32x4*)(conv_b + DFF + jj) + *(const f32x4*)(conv_w + DFF + jj) * *(const f32x4*)(r2 + cc + 128) + *(const f32x4*)(conv_w + FF2 + DFF + jj) * *(const f32x4*)(r1 + cc + 128) + *(const f32x4*)(conv_w + 2 * (size_t)FF2 + DFF + jj) * *(const f32x4*)(r0 + cc + 128);
#pragma unroll
                for (int e = 0; e < 4; ++e) o[q][e] = gelu_tanh(cgv[e]) * cuv[e]; }
            *(u32x4*)(ACT + (size_t)(pm * 256 + rr) * DFF + ch) = pack8(o[0], o[1]); }
    }
    xcd_barrier(xbar);
    { pg8::Gemm g{ACT, W_FOUT, DFF, DFF, DFF}; pg8::Order S; S.init(64, 8, G, bid, 0); EpiF32Stat E{MO3, STAT}; pg8::gemm_phase(lds, g, S, E); }
    xcd_barrier(xbar);

    { PHASE_IDS for (int m = gw; m < S_; m += NGW) resid_row<false>(a.out + (size_t)m * DM, MO3 + (size_t)m * DM, STAT + (size_t)m * 32, (const float*)a.in[26], a.out + (size_t)m * DM, nullptr, nullptr, lane); }
#endif
}

constexpr int LDS_BYTES = 152 * 1024;
static_assert(att::LDS_BYTES <= LDS_BYTES - 64 && pg8::STAGE_BYTES + 8192 <= LDS_BYTES - 64, "LDS map");
extern "C" void kernel_launch(void* const* d_in, const int* in_sizes, int n_in, void* d_out, int out_size, void* d_ws, size_t ws_size, hipStream_t stream) {
    static int grid = 0;
    if (grid == 0) {
        if (n_in != 27 || in_sizes[0] != S_ * DM || out_size != S_ * DM || ws_size < WS_END) { fprintf(stderr, "kernel_launch: unexpected shapes (n_in %d, in0 %d, out %d, ws %zu)\n", n_in, n_in > 0 ? in_sizes[0] : -1, out_size, ws_size); grid = -1; return; }
        int dev = 0, cus = 0, per_cu = 0;
        (void)hipGetDevice(&dev); (void)hipDeviceGetAttribute(&cus, hipDeviceAttributeMultiprocessorCount, dev);
        if (hipFuncSetAttribute((const void*)fwd_megakernel, hipFuncAttributeMaxDynamicSharedMemorySize, LDS_BYTES) != hipSuccess) { fprintf(stderr, "kernel_launch: hipFuncSetAttribute failed\n"); grid = -1; return; }
        if (hipOccupancyMaxActiveBlocksPerMultiprocessor(&per_cu, (const void*)fwd_megakernel, NTHREADS, LDS_BYTES) != hipSuccess || per_cu < 1) { fprintf(stderr, "kernel_launch: occupancy query gave %d\n", per_cu); per_cu = 1; }
        (void)hipGetLastError();
        if (cus <= 0) cus = 256;
        grid = cus * (per_cu > 1 ? 1 : per_cu);
    }
    if (grid < 0) return;
    Args a{};
    for (int i = 0; i < 27; ++i) a.in[i] = d_in[i];
    a.out = (float*)d_out; a.ws = (unsigned char*)d_ws;
    for (int i = 0; i < 32; ++i) a.inv_freq[i] = (float)pow(10000.0, -(double)i / 32.0);
    void* args[] = {&a};
    hipError_t e = hipLaunchCooperativeKernel((const void*)fwd_megakernel, dim3(grid), dim3(NTHREADS), args, LDS_BYTES, stream);
    if (e != hipSuccess) fprintf(stderr, "kernel_launch: cooperative launch failed: %s (grid %d)\n", hipGetErrorString(e), grid);
}
```

```cpp
#include <hip/hip_runtime.h>
#include <hip/hip_cooperative_groups.h>
#include <cstdio>
#include <cstdint>
#include <cmath>
namespace cg = cooperative_groups;

#define LAS __attribute__((address_space(3)))
typedef unsigned short bf16_t;
typedef short bf16x8 __attribute__((ext_vector_type(8)));
typedef short s16x4 __attribute__((ext_vector_type(4)));
typedef float f32x4 __attribute__((ext_vector_type(4)));
typedef float f32x2 __attribute__((ext_vector_type(2)));
typedef float f32x16 __attribute__((ext_vector_type(16)));
typedef unsigned u32x4 __attribute__((ext_vector_type(4)));
typedef unsigned u32x2 __attribute__((ext_vector_type(2)));

constexpr int S_ = 16384, DM = 2048, DIN = 6208, DINP = 6400, QL = 512;
constexpr int NH = 16, DQK = 192, DN = 128, DR = 64, DV = 128, QW = NH * DQK  , KVW = NH * 256  ;
constexpr int PW = 1024, NMEM = 256, MHD = 512, DFF = 5632, FF2 = 11264, FFH = 2816;
constexpr float EPS = 1e-6f;
constexpr int NTHREADS = 512, NWAVES = 8;

constexpr size_t MiB = 1u << 20;
constexpr size_t WS_W_IN = 0, WS_W_QB = 25 * MiB, WS_W_KVB = 28 * MiB, WS_W_ATT = 32 * MiB, WS_W_PG = 40 * MiB, WS_W_PBR = 41 * MiB,
                 WS_W_MIX = 45 * MiB, WS_W_MQ = 53 * MiB, WS_W_MKV = 61 * MiB, WS_W_MO = 77 * MiB, WS_W_FIN = 85 * MiB, WS_W_FOUT = 129 * MiB;
constexpr size_t WS_ROPE = 151 * MiB, WS_STAT = 155 * MiB, WS_KPE = 157 * MiB, WS_MEMN = 159 * MiB;
constexpr size_t WS_MEMK = 0, WS_VMT = 1 * MiB;
constexpr size_t WS_H3 = 0;
constexpr size_t WS_QC = 160 * MiB, WS_U = 192 * MiB, WS_GA = 224 * MiB, WS_GP = 288 * MiB, WS_D = 352 * MiB, WS_KV = 384 * MiB;
constexpr size_t WS_AO = 160 * MiB, WS_MERGED = 352 * MiB, WS_MO = 160 * MiB, WS_H2 = 288 * MiB, WS_QM = 352 * MiB, WS_PM = 416 * MiB;
constexpr size_t WS_OM = 160 * MiB, WS_MO2 = 224 * MiB, WS_AH = 160 * MiB, WS_ACT = 336 * MiB, WS_MO3 = 160 * MiB;
constexpr size_t WS_END = 512 * MiB;
constexpr size_t DO_H = 0, DO_Q = 0, DO_PD = 96 * MiB;

typedef __bf16 bf16x2_t __attribute__((ext_vector_type(2)));
__device__ __forceinline__ unsigned cvt_pk(float lo, float hi) { f32x2 v = {lo, hi}; bf16x2_t b = __builtin_convertvector(v, bf16x2_t); return __builtin_bit_cast(unsigned, b); }
__device__ __forceinline__ float bf_lo(unsigned u) { return __uint_as_float(u << 16); }
__device__ __forceinline__ float bf_hi(unsigned u) { return __uint_as_float(u & 0xffff0000u); }
__device__ __forceinline__ u32x4 pack8(f32x4 a, f32x4 b) { u32x4 w; w.x = cvt_pk(a[0], a[1]); w.y = cvt_pk(a[2], a[3]); w.z = cvt_pk(b[0], b[1]); w.w = cvt_pk(b[2], b[3]); return w; }
__device__ __forceinline__ void unpack8(u32x4 w, f32x4& a, f32x4& b) { a = (f32x4){bf_lo(w.x), bf_hi(w.x), bf_lo(w.y), bf_hi(w.y)}; b = (f32x4){bf_lo(w.z), bf_hi(w.z), bf_lo(w.w), bf_hi(w.w)}; }
__device__ __forceinline__ float sigmoidf_(float x) { return __builtin_amdgcn_rcpf(1.f + __expf(-x)); }
__device__ __forceinline__ float wave_sum(float v) {
#pragma unroll
    for (int o = 1; o < 64; o <<= 1) v += __shfl_xor(v, o);
    return v;
}
#define LDS_WAIT() asm volatile("s_waitcnt lgkmcnt(0)" ::: "memory")
__device__ __forceinline__ int fresh_tid() { int t = threadIdx.x; asm volatile("" : "+v"(t)); return t; }

namespace pg8 {
constexpr int BM = 256, BK = 64, HALF = 128, HTB = HALF * BK * 2, STAGE_BYTES = 8 * HTB, NXCD = 8, WGM = 8;
__host__ __device__ __forceinline__ int lds_byte(int r, int c) { const int st = (r >> 4) * 2 + (c >> 5), rr = r & 15, cc = c & 31, ob = rr * 64 + cc * 2; return st * 1024 + (ob ^ (((ob >> 9) & 1) << 5)); }
__host__ __device__ __forceinline__ void stage_rc(int b, int& R, int& C) { const int st = b / 1024, sb = b % 1024, swz = sb ^ (((sb >> 9) & 1) << 5); R = (st >> 1) * 16 + swz / 64; C = (st & 1) * 32 + (swz % 64) / 2; }
__host__ __device__ __forceinline__ int perm32(int rho) { const int n = rho >> 4, i = rho & 15; return 8 * (i >> 2) + 4 * n + (i & 3); }

struct Unit { int pm, pn; };
struct Gemm { const bf16_t* A; const bf16_t* Bt; int lda, ldb, K; };

struct Order {
    int nM, nN, nwg, G, c;
    __device__ __forceinline__ void init(int nM_, int nN_, int G_, int bid, int rot) { nM = nM_; nN = nN_; nwg = nM * nN; G = G_; c = (bid + G_ - (rot % G_)) % G_; }
    __device__ __forceinline__ bool next(int i, Unit& u) const {
        const long L = (long)i * G + c; if (L >= nwg) return false;
        int wgid = (int)L; { const int q = nwg / NXCD, r = nwg % NXCD, xcd = wgid % NXCD, off = wgid / NXCD; wgid = (xcd < r ? xcd * (q + 1) : r * (q + 1) + (xcd - r) * q) + off; }
        const int nig = WGM * nN, gid = wgid / nig, fm = gid * WGM, gsz = (nM - fm) < WGM ? (nM - fm) : WGM;
        u.pm = fm + ((wgid % nig) % gsz); u.pn = (wgid % nig) / gsz; return true;
    }
};

template <class Epi, bool APERM = false, bool NARROW = false>
__device__ __forceinline__ void gemm_phase(LAS unsigned char* lds, const Gemm g, const Order& S, const Epi& E) {
    const int tid = fresh_tid(), wid = __builtin_amdgcn_readfirstlane(tid >> 6), lane = tid & 63, wr = wid >> 2, wc = wid & 3, fr = lane & 15, fq = lane >> 4;
    const int K = g.K, nt = K / BK;
    unsigned voffA[2], voffB[2];
#pragma unroll
    for (int i = 0; i < 2; ++i) { int R, C; stage_rc(tid * 16 + i * 8192, R, C); const int Rb = (R & ~31) + perm32(R & 31);
        const int Ra = APERM ? ((R & ~63) + 4 * (R & 15) + ((R >> 4) & 3)) : R;
        voffA[i] = (unsigned)(Ra * g.lda + C) * 2u; voffB[i] = (unsigned)(Rb * g.ldb + C) * 2u; }
    const size_t kstep = (size_t)(BK * 2);
    const size_t hstepA = (size_t)HALF * g.lda * 2, hstepB = (size_t)HALF * g.ldb * 2;
    const size_t tstepA = 2 * hstepA, tstepB = 2 * hstepB;
    const unsigned ldsw = (unsigned)wid * 1024u;
    const int aoff = lds_byte(wr * 64 + fr, fq * 8), boff = lds_byte(wc * 32 + fr, fq * 8);
#define PG8_SA(b, h) (((b) * 2 + (h)) * HTB)
#define PG8_SB(b, h) ((4 + (b) * 2 + (h)) * HTB)
#define PG8_STAGE(bufoff, gbase, voff) do { _Pragma("unroll") for (int _i = 0; _i < 2; ++_i) \
        __builtin_amdgcn_global_load_lds((const unsigned*)((const char*)(gbase) + (voff)[_i]), (LAS unsigned*)(lds + (bufoff) + ldsw + _i * 8192), 16, 0, 0); } while (0)
#define PG8_LDA(dst, b, h) do { _Pragma("unroll") for (int m = 0; m < 4; ++m) _Pragma("unroll") for (int k = 0; k < 2; ++k) dst[m][k] = *(const LAS bf16x8*)(lds + PG8_SA(b, h) + aoff + m * 2048 + k * 1024); } while (0)
#define PG8_LDB(dst, b, h) do { _Pragma("unroll") for (int n = 0; n < 2; ++n) _Pragma("unroll") for (int k = 0; k < 2; ++k) dst[n][k] = *(const LAS bf16x8*)(lds + PG8_SB(b, h) + boff + n * 2048 + k * 1024); } while (0)
#define PG8_MMA(ai, bj, At, Bt) do { __builtin_amdgcn_s_setprio(1); _Pragma("unroll") for (int m = 0; m < 4; ++m) _Pragma("unroll") for (int n = 0; n < 2; ++n) _Pragma("unroll") for (int k = 0; k < 2; ++k) \
        acc[ai][bj][m][n] = __builtin_amdgcn_mfma_f32_16x16x32_bf16(Bt[n][k], At[m][k], acc[ai][bj][m][n], 0, 0, 0); __builtin_amdgcn_s_setprio(0); } while (0)
#define PG8_WAIT_V(n) asm volatile("s_waitcnt vmcnt(" #n ")" ::: "memory")
#define PG8_WAIT_L(n) asm volatile("s_waitcnt lgkmcnt(" #n ")" ::: "memory")
#define PG8_BAR __builtin_amdgcn_s_barrier()
#define PG8_SCHED __builtin_amdgcn_sched_barrier(0)
    Unit cur, nxt; int ui = 0;
    if (!S.next(0, cur)) return;
    f32x4 acc[2][2][4][2];
#pragma unroll
    for (int a = 0; a < 2; ++a)
#pragma unroll
        for (int b = 0; b < 2; ++b)
#pragma unroll
            for (int m = 0; m < 4; ++m)
#pragma unroll
                for (int n = 0; n < 2; ++n) acc[a][b][m][n] = (f32x4){0.f, 0.f, 0.f, 0.f};
    bf16x8 At[4][2], B0[2][2], B1[2][2];
    const char* cA = (const char*)g.A + (size_t)cur.pm * tstepA; const char* cB = (const char*)g.Bt + (size_t)cur.pn * tstepB;
    PG8_STAGE(PG8_SB(0, 0), cB, voffB); PG8_STAGE(PG8_SB(0, 1), cB + hstepB, voffB); PG8_STAGE(PG8_SA(0, 0), cA, voffA); PG8_STAGE(PG8_SA(0, 1), cA + hstepA, voffA);
    if (wr == 1) PG8_BAR;
    PG8_WAIT_V(2); PG8_BAR;
    PG8_STAGE(PG8_SB(1, 0), cB + kstep, voffB); PG8_STAGE(PG8_SA(1, 0), cA + kstep, voffA); PG8_STAGE(PG8_SB(1, 1), cB + hstepB + kstep, voffB);
    PG8_WAIT_V(6); PG8_BAR;
    for (;;) {
        const bool has_next = S.next(ui + 1, nxt);
        bool live0 = true, live1 = true; if constexpr (NARROW) { if (cur.pn == Epi::NARROW_PN) { live1 = false; live0 = wc < 2; } }
        const char* nA = has_next ? (const char*)g.A + (size_t)nxt.pm * tstepA : cA; const char* nB = has_next ? (const char*)g.Bt + (size_t)nxt.pn * tstepB : cB;
        for (int t = 0; t < nt; t += 2) {
            const bool last = (t == nt - 2);
            const char* a1 = cA + (size_t)(t + 1) * kstep;
            const char* a2 = last ? nA : cA + (size_t)(t + 2) * kstep; const char* b2 = last ? nB : cB + (size_t)(t + 2) * kstep;
            const char* a3 = a2 + kstep; const char* b3 = b2 + kstep;
            PG8_LDB(B0, 0, 0); PG8_LDB(B1, 0, 1); PG8_SCHED; PG8_LDA(At, 0, 0); PG8_STAGE(PG8_SA(1, 1), a1 + hstepA, voffA);
            PG8_WAIT_V(8); PG8_WAIT_L(0); PG8_BAR; if (live0) PG8_MMA(0, 0, At, B0); if (live1) PG8_MMA(0, 1, At, B1); PG8_BAR; PG8_SCHED;
            PG8_LDA(At, 0, 1); PG8_STAGE(PG8_SB(0, 0), b2, voffB); PG8_STAGE(PG8_SB(0, 1), b2 + hstepB, voffB); PG8_STAGE(PG8_SA(0, 0), a2, voffA);
            PG8_WAIT_V(8); PG8_WAIT_L(0); PG8_BAR; if (live0) PG8_MMA(1, 0, At, B0); if (live1) PG8_MMA(1, 1, At, B1); PG8_BAR; PG8_SCHED;
            PG8_LDB(B0, 1, 0); PG8_LDB(B1, 1, 1); PG8_SCHED; PG8_LDA(At, 1, 0); PG8_STAGE(PG8_SA(0, 1), a2 + hstepA, voffA);
            PG8_WAIT_V(8); PG8_WAIT_L(0); PG8_BAR; if (live0) PG8_MMA(0, 0, At, B0); if (live1) PG8_MMA(0, 1, At, B1); PG8_BAR; PG8_SCHED;
            PG8_LDA(At, 1, 1); PG8_STAGE(PG8_SB(1, 0), b3, voffB); PG8_STAGE(PG8_SB(1, 1), b3 + hstepB, voffB); PG8_STAGE(PG8_SA(1, 0), a3, voffA);
            PG8_WAIT_V(8); PG8_WAIT_L(0); PG8_BAR; if (live0) PG8_MMA(1, 0, At, B0); if (live1) PG8_MMA(1, 1, At, B1); PG8_BAR; PG8_SCHED;
        }
        if (wr == 0) PG8_BAR;
        E(acc, cur, wr, wc, fr, fq);
        if (!has_next) break;
#pragma unroll
        for (int a = 0; a < 2; ++a)
#pragma unroll
            for (int b = 0; b < 2; ++b)
#pragma unroll
                for (int m = 0; m < 4; ++m)
#pragma unroll
                    for (int n = 0; n < 2; ++n) acc[a][b][m][n] = (f32x4){0.f, 0.f, 0.f, 0.f};
        cur = nxt; cA = nA; cB = nB; ++ui;
        if (wr == 1) PG8_BAR;
    }
    PG8_WAIT_V(0);
    PG8_BAR;
#undef PG8_SA
#undef PG8_SB
#undef PG8_STAGE
#undef PG8_LDA
#undef PG8_LDB
#undef PG8_MMA
#undef PG8_WAIT_V
#undef PG8_WAIT_L
#undef PG8_BAR
#undef PG8_SCHED
}
}
using pg8::Unit;
typedef f32x4 Acc[2][2][4][2];

#define EPI_ARGS const Acc& acc, const Unit& u, int wr, int wc, int fr, int fq
#define EPI_ROWCOL const int row0 = u.pm * 256 + wr * 64 + fr; const int ct0 = wc * 32 + 8 * fq;

struct EpiStore {
    bf16_t* O; int ldo; int coff;
    __device__ __forceinline__ void operator()(EPI_ARGS) const { EPI_ROWCOL
#pragma unroll
        for (int ai = 0; ai < 2; ++ai)
#pragma unroll
            for (int m = 0; m < 4; ++m) { bf16_t* rp = O + (size_t)(row0 + ai * 128 + m * 16) * ldo + coff + u.pn * 256 + ct0;
#pragma unroll
                for (int bj = 0; bj < 2; ++bj) *(u32x4*)(rp + bj * 128) = pack8(acc[ai][bj][m][0], acc[ai][bj][m][1]); }
    }
};
struct EpiIn {
    static constexpr int NARROW_PN = 4;
    bf16_t *QC, *U, *GA, *GP, *KPE; float* STAT; const f32x2* ROPE;
    __device__ __forceinline__ void operator()(EPI_ARGS) const { EPI_ROWCOL
        const int pn = u.pn;
        if (pn < 4) {
#pragma unroll
            for (int ai = 0; ai < 2; ++ai)
#pragma unroll
                for (int m = 0; m < 4; ++m) { const int row = row0 + ai * 128 + m * 16; float s = 0.f;
#pragma unroll
                    for (int bj = 0; bj < 2; ++bj) { const f32x4 v0 = acc[ai][bj][m][0], v1 = acc[ai][bj][m][1];
                        s += (v0[0] * v0[0] + v0[1] * v0[1]) + (v0[2] * v0[2] + v0[3] * v0[3]) + (v1[0] * v1[0] + v1[1] * v1[1]) + (v1[2] * v1[2] + v1[3] * v1[3]);
                        *(u32x4*)(QC + (size_t)row * 1024 + pn * 256 + bj * 128 + ct0) = pack8(v0, v1); }
                    s += __shfl_xor(s, 16); s += __shfl_xor(s, 32);
                    if (fq == 0) STAT[(size_t)row * 32 + pn * 4 + wc] = s; }
        } else if (pn == 4) {
            if (wc < 2) { const int i0 = 16 * wc + 4 * fq;
#pragma unroll
                for (int ai = 0; ai < 2; ++ai)
#pragma unroll
                    for (int m = 0; m < 4; ++m) { const int row = row0 + ai * 128 + m * 16; const f32x4 v0 = acc[ai][0][m][0], v1 = acc[ai][0][m][1];
                        const f32x4 cs0 = *(const f32x4*)(ROPE + (size_t)row * 32 + i0), cs1 = *(const f32x4*)(ROPE + (size_t)row * 32 + i0 + 2);
                        const float a0 = v0[0] * cs0[0] - v0[1] * cs0[1], b0 = v0[1] * cs0[0] + v0[0] * cs0[1];
                        const float a1 = v0[2] * cs0[2] - v0[3] * cs0[3], b1 = v0[3] * cs0[2] + v0[2] * cs0[3];
                        const float a2 = v1[0] * cs1[0] - v1[1] * cs1[1], b2 = v1[1] * cs1[0] + v1[0] * cs1[1];
                        const float a3 = v1[2] * cs1[2] - v1[3] * cs1[3], b3 = v1[3] * cs1[2] + v1[2] * cs1[3];
                        u32x2 wa, wb; wa.x = cvt_pk(a0, a1); wa.y = cvt_pk(a2, a3); wb.x = cvt_pk(b0, b1); wb.y = cvt_pk(b2, b3);
                        *(u32x2*)(KPE + (size_t)row * 64 + i0) = wa; *(u32x2*)(KPE + (size_t)row * 64 + 32 + i0) = wb; } }
        } else if (pn < 9) {
#pragma unroll
            for (int ai = 0; ai < 2; ++ai)
#pragma unroll
                for (int m = 0; m < 4; ++m) { const int row = row0 + ai * 128 + m * 16;
#pragma unroll
                    for (int bj = 0; bj < 2; ++bj) *(u32x4*)(U + (size_t)row * 1024 + (pn - 5) * 256 + bj * 128 + ct0) = pack8(acc[ai][bj][m][0], acc[ai][bj][m][1]); }
        } else {
            bf16_t* G = pn < 17 ? GA : GP; const int pc = (pn < 17 ? pn - 9 : pn - 17) * 256;
#pragma unroll
            for (int ai = 0; ai < 2; ++ai)
#pragma unroll
                for (int m = 0; m < 4; ++m) { const int row = row0 + ai * 128 + m * 16;
#pragma unroll
                    for (int bj = 0; bj < 2; ++bj) { f32x4 v0 = acc[ai][bj][m][0], v1 = acc[ai][bj][m][1];
#pragma unroll
                        for (int e = 0; e < 4; ++e) { v0[e] = sigmoidf_(v0[e]); v1[e] = sigmoidf_(v1[e]); }
                        *(u32x4*)(G + (size_t)row * 2048 + pc + bj * 128 + ct0) = pack8(v0, v1); } }
        }
    }
};
__device__ __forceinline__ float rstd8(const float* st) { const f32x4 a = *(const f32x4*)st, b = *(const f32x4*)(st + 4); const float s = (a[0] + a[1]) + (a[2] + a[3]) + (b[0] + b[1]) + (b[2] + b[3]); return 1.0f / sqrtf(s * (1.0f / 512.0f) + EPS); }
struct EpiQ {
    bf16_t* Q; const float* STAT; const f32x2* ROPE;
    __device__ __forceinline__ void operator()(EPI_ARGS) const { EPI_ROWCOL
        const int pn = u.pn;
#pragma unroll
        for (int ai = 0; ai < 2; ++ai)
#pragma unroll
            for (int m = 0; m < 4; ++m) { const int row = row0 + ai * 128 + m * 16; const float rs = rstd8(STAT + (size_t)row * 32);
                if (pn < 8) {
#pragma unroll
                    for (int bj = 0; bj < 2; ++bj) *(u32x4*)(Q + (size_t)row * QW + (2 * pn + bj) * DQK + ct0) = pack8(acc[ai][bj][m][0] * rs, acc[ai][bj][m][1] * rs);
                } else { const int i0 = 16 * (wc & 1) + 4 * fq;
                    const f32x4 cs0 = *(const f32x4*)(ROPE + (size_t)row * 32 + i0), cs1 = *(const f32x4*)(ROPE + (size_t)row * 32 + i0 + 2);
#pragma unroll
                    for (int bj = 0; bj < 2; ++bj) { const int head = 4 * (pn - 8) + 2 * bj + (wc >> 1); const f32x4 v0 = acc[ai][bj][m][0] * rs, v1 = acc[ai][bj][m][1] * rs;
                        const float a0 = v0[0] * cs0[0] - v0[1] * cs0[1], b0 = v0[1] * cs0[0] + v0[0] * cs0[1];
                        const float a1 = v0[2] * cs0[2] - v0[3] * cs0[3], b1 = v0[3] * cs0[2] + v0[2] * cs0[3];
                        const float a2 = v1[0] * cs1[0] - v1[1] * cs1[1], b2 = v1[1] * cs1[0] + v1[0] * cs1[1];
                        const float a3 = v1[2] * cs1[2] - v1[3] * cs1[3], b3 = v1[3] * cs1[2] + v1[2] * cs1[3];
                        u32x2 wa, wb; wa.x = cvt_pk(a0, a1); wa.y = cvt_pk(a2, a3); wb.x = cvt_pk(b0, b1); wb.y = cvt_pk(b2, b3);
                        bf16_t* qp = Q + (size_t)row * QW + head * DQK + DN + i0; *(u32x2*)qp = wa; *(u32x2*)(qp + 32) = wb; } }
            }
    }
};
struct EpiKV {
    bf16_t* KV; const float* STAT;
    __device__ __forceinline__ void operator()(EPI_ARGS) const { EPI_ROWCOL
#pragma unroll
        for (int ai = 0; ai < 2; ++ai)
#pragma unroll
            for (int m = 0; m < 4; ++m) { const int row = row0 + ai * 128 + m * 16; const float rs = rstd8(STAT + (size_t)row * 32 + 8);
#pragma unroll
                for (int bj = 0; bj < 2; ++bj) *(u32x4*)(KV + (size_t)row * KVW + u.pn * 256 + bj * 128 + ct0) = pack8(acc[ai][bj][m][0] * rs, acc[ai][bj][m][1] * rs); }
    }
};
struct EpiMemKV {
    bf16_t *MEMK, *VMT;
    __device__ __forceinline__ void operator()(EPI_ARGS) const { EPI_ROWCOL
#pragma unroll
        for (int ai = 0; ai < 2; ++ai)
#pragma unroll
            for (int m = 0; m < 4; ++m) { const int row = row0 + ai * 128 + m * 16;
#pragma unroll
                for (int bj = 0; bj < 2; ++bj) { const u32x4 w = pack8(acc[ai][bj][m][0], acc[ai][bj][m][1]); const int col = u.pn * 256 + bj * 128 + ct0;
                    if (u.pn < 8) *(u32x4*)(MEMK + (size_t)row * 2048 + col) = w;
                    else { bf16_t* vp = VMT + (size_t)(col - 2048) * 256 + row;
                        vp[0 * 256] = (bf16_t)(w.x & 0xffff); vp[1 * 256] = (bf16_t)(w.x >> 16); vp[2 * 256] = (bf16_t)(w.y & 0xffff); vp[3 * 256] = (bf16_t)(w.y >> 16);
                        vp[4 * 256] = (bf16_t)(w.z & 0xffff); vp[5 * 256] = (bf16_t)(w.z >> 16); vp[6 * 256] = (bf16_t)(w.w & 0xffff); vp[7 * 256] = (bf16_t)(w.w >> 16); } } }
    }
};
template <int PASS> struct EpiMerge {
    bf16_t* T; const bf16_t* G;
    __device__ __forceinline__ void operator()(EPI_ARGS) const { EPI_ROWCOL
#pragma unroll
        for (int ai = 0; ai < 2; ++ai)
#pragma unroll
            for (int m = 0; m < 4; ++m) { const size_t ro = (size_t)(row0 + ai * 128 + m * 16) * 2048 + u.pn * 256 + ct0;
#pragma unroll
                for (int bj = 0; bj < 2; ++bj) { f32x4 g0, g1; unpack8(*(const u32x4*)(G + ro + bj * 128), g0, g1);
                    f32x4 v0 = acc[ai][bj][m][0] * g0, v1 = acc[ai][bj][m][1] * g1;
                    if (PASS == 1) { f32x4 t0, t1; unpack8(*(const u32x4*)(T + ro + bj * 128), t0, t1); v0 += t0; v1 += t1; }
                    *(u32x4*)(T + ro + bj * 128) = pack8(v0, v1); } }
    }
};
struct EpiF32Stat {
    bf16_t* O; float* STAT;
    __device__ __forceinline__ void operator()(EPI_ARGS) const { EPI_ROWCOL
#pragma unroll
        for (int ai = 0; ai < 2; ++ai)
#pragma unroll
            for (int m = 0; m < 4; ++m) { const int row = row0 + ai * 128 + m * 16; float s = 0.f;
#pragma unroll
                for (int bj = 0; bj < 2; ++bj) { const f32x4 v0 = acc[ai][bj][m][0], v1 = acc[ai][bj][m][1];
                    s += (v0[0] * v0[0] + v0[1] * v0[1]) + (v0[2] * v0[2] + v0[3] * v0[3]) + (v1[0] * v1[0] + v1[1] * v1[1]) + (v1[2] * v1[2] + v1[3] * v1[3]);
                    *(u32x4*)(O + (size_t)row * 2048 + u.pn * 256 + bj * 128 + ct0) = pack8(v0, v1); }
                s += __shfl_xor(s, 16); s += __shfl_xor(s, 32);
                if (fq == 0) STAT[(size_t)row * 32 + u.pn * 4 + wc] = s; }
    }
};
struct EpiSoftmax {
    bf16_t* PM; int coff; LAS f32x2* part;
    __device__ __forceinline__ void operator()(EPI_ARGS) const { EPI_ROWCOL
        constexpr float SC2 = 0.044194173824159216f * 1.4426950408889634f;
        float mloc[2][4];
#pragma unroll
        for (int ai = 0; ai < 2; ++ai)
#pragma unroll
            for (int m = 0; m < 4; ++m) { float mx = -3.0e38f;
#pragma unroll
                for (int bj = 0; bj < 2; ++bj)
#pragma unroll
                    for (int n = 0; n < 2; ++n)
#pragma unroll
                        for (int e = 0; e < 4; ++e) mx = fmaxf(mx, acc[ai][bj][m][n][e]);
                mx = fmaxf(mx, __shfl_xor(mx, 16)); mx = fmaxf(mx, __shfl_xor(mx, 32));
                float s = 0.f;
#pragma unroll
                for (int bj = 0; bj < 2; ++bj)
#pragma unroll
                    for (int n = 0; n < 2; ++n)
#pragma unroll
                        for (int e = 0; e < 4; ++e) s += __builtin_amdgcn_exp2f((acc[ai][bj][m][n][e] - mx) * SC2);
                s += __shfl_xor(s, 16); s += __shfl_xor(s, 32);
                mloc[ai][m] = mx;
                if (fq == 0) part[(ai * 128 + wr * 64 + m * 16 + fr) * 4 + wc] = (f32x2){mx, s}; }
        LDS_WAIT(); __builtin_amdgcn_s_barrier(); asm volatile("" ::: "memory");
#pragma unroll
        for (int ai = 0; ai < 2; ++ai)
#pragma unroll
            for (int m = 0; m < 4; ++m) { const int rl = ai * 128 + wr * 64 + m * 16 + fr;
                const f32x2 p0 = part[rl * 4 + 0], p1 = part[rl * 4 + 1], p2 = part[rl * 4 + 2], p3 = part[rl * 4 + 3];
                const float M = fmaxf(fmaxf(p0.x, p1.x), fmaxf(p2.x, p3.x));
                const float L = p0.y * __builtin_amdgcn_exp2f((p0.x - M) * SC2) + p1.y * __builtin_amdgcn_exp2f((p1.x - M) * SC2) + p2.y * __builtin_amdgcn_exp2f((p2.x - M) * SC2) + p3.y * __builtin_amdgcn_exp2f((p3.x - M) * SC2);
                const float inv = 1.0f / L;
                bf16_t* rp = PM + (size_t)(row0 + ai * 128 + m * 16) * 1024 + coff + ct0;
#pragma unroll
                for (int bj = 0; bj < 2; ++bj) { f32x4 v0 = acc[ai][bj][m][0], v1 = acc[ai][bj][m][1];
#pragma unroll
                    for (int e = 0; e < 4; ++e) { v0[e] = __builtin_amdgcn_exp2f((v0[e] - M) * SC2) * inv; v1[e] = __builtin_amdgcn_exp2f((v1[e] - M) * SC2) * inv; }
                    *(u32x4*)(rp + bj * 128) = pack8(v0, v1); } }
        LDS_WAIT(); __builtin_amdgcn_s_barrier(); asm volatile("" ::: "memory");
    }
};

__device__ __forceinline__ float gelu_tanh(float x) { const float y2 = 1.5957691216057308f * (x + 0.044715f * x * x * x); return x * __builtin_amdgcn_rcpf(1.f + __expf(-y2)); }

template <int CTRL> __device__ __forceinline__ float dppf(float old, float src) { return __int_as_float(__builtin_amdgcn_update_dpp(__float_as_int(old), __float_as_int(src), CTRL, 0xf, 0xf, false)); }
struct EpiFfn {
    bf16_t* ACTp; float* HALO; const float* conv_w; const float* conv_b; LAS float* xbuf;
    __device__ __forceinline__ void operator()(EPI_ARGS) const {
        const int rowb = u.pm * 256 + wr * 64 + 4 * fr; const int ct0 = wc * 32 + 8 * fq;
        const int ch0 = u.pn * 128 + ct0;
#pragma unroll
        for (int ai = 0; ai < 2; ++ai) if (fr == 15) {
#pragma unroll
            for (int bj = 0; bj < 2; ++bj)
#pragma unroll
                for (int n = 0; n < 2; ++n) { *(LAS f32x4*)(xbuf + ((2 * ai + wr) * 2 + 0) * 256 + bj * 128 + ct0 + 4 * n) = acc[ai][bj][2][n]; *(LAS f32x4*)(xbuf + ((2 * ai + wr) * 2 + 1) * 256 + bj * 128 + ct0 + 4 * n) = acc[ai][bj][3][n]; } }
        if (wr == 1 && fr == 15) {
#pragma unroll
            for (int bj = 0; bj < 2; ++bj)
#pragma unroll
                for (int n = 0; n < 2; ++n) { *(f32x4*)(HALO + ((size_t)u.pm * 4 + 2) * FF2 + u.pn * 256 + bj * 128 + ct0 + 4 * n) = acc[1][bj][2][n]; *(f32x4*)(HALO + ((size_t)u.pm * 4 + 3) * FF2 + u.pn * 256 + bj * 128 + ct0 + 4 * n) = acc[1][bj][3][n]; } }
        if (wr == 0 && fr == 0) {
#pragma unroll
            for (int bj = 0; bj < 2; ++bj)
#pragma unroll
                for (int n = 0; n < 2; ++n) { *(f32x4*)(HALO + ((size_t)u.pm * 4 + 0) * FF2 + u.pn * 256 + bj * 128 + ct0 + 4 * n) = acc[0][bj][0][n]; *(f32x4*)(HALO + ((size_t)u.pm * 4 + 1) * FF2 + u.pn * 256 + bj * 128 + ct0 + 4 * n) = acc[0][bj][1][n]; } }
        LDS_WAIT(); __builtin_amdgcn_s_barrier(); asm volatile("" ::: "memory");
#pragma unroll
        for (int n = 0; n < 2; ++n) {
            f32x4 wg[3], wu[3], bg, bu;
#pragma unroll
            for (int k = 0; k < 3; ++k) { wg[k] = *(const f32x4*)(conv_w + (size_t)k * FF2 + ch0 + 4 * n); wu[k] = *(const f32x4*)(conv_w + (size_t)k * FF2 + DFF + ch0 + 4 * n); }
            bg = *(const f32x4*)(conv_b + ch0 + 4 * n); bu = *(const f32x4*)(conv_b + DFF + ch0 + 4 * n);
#pragma unroll
            for (int ai = 0; ai < 2; ++ai) { const int c = 2 * ai + wr;
                f32x4 cv[2][4];
#pragma unroll
                for (int bj = 0; bj < 2; ++bj) { f32x4 h1 = (f32x4){0.f, 0.f, 0.f, 0.f}, h0 = h1;
                    if (c > 0) { h0 = *(const LAS f32x4*)(xbuf + ((c - 1) * 2 + 0) * 256 + bj * 128 + ct0 + 4 * n); h1 = *(const LAS f32x4*)(xbuf + ((c - 1) * 2 + 1) * 256 + bj * 128 + ct0 + 4 * n); }
                    const f32x4 x0 = acc[ai][bj][0][n], x1 = acc[ai][bj][1][n], x2 = acc[ai][bj][2][n], x3 = acc[ai][bj][3][n]; f32x4 s3, s2;
#pragma unroll
                    for (int e = 0; e < 4; ++e) { s3[e] = dppf<0x111>(h1[e], x3[e]); s2[e] = dppf<0x111>(h0[e], x2[e]); }
                    const f32x4 w0 = bj == 0 ? wg[0] : wu[0], w1 = bj == 0 ? wg[1] : wu[1], w2 = bj == 0 ? wg[2] : wu[2], bb = bj == 0 ? bg : bu;
                    cv[bj][0] = bb + w0 * s2 + w1 * s3 + w2 * x0;
                    cv[bj][1] = bb + w0 * s3 + w1 * x0 + w2 * x1;
                    cv[bj][2] = bb + w0 * x0 + w1 * x1 + w2 * x2;
                    cv[bj][3] = bb + w0 * x1 + w1 * x2 + w2 * x3; }
#pragma unroll
                for (int m = 0; m < 4; ++m) { f32x4 o;
#pragma unroll
                    for (int e = 0; e < 4; ++e) o[e] = gelu_tanh(cv[0][m][e]) * cv[1][m][e];
                    u32x2 w; w.x = cvt_pk(o[0], o[1]); w.y = cvt_pk(o[2], o[3]);
                    *(u32x2*)(ACTp + (size_t)(rowb + ai * 128 + m) * DFF + ch0 + 4 * n) = w; } } }
    }
};

namespace att {
constexpr int NW = 8, QBLK = 32, KVBLK = 64, QB = 256;
constexpr int SHM_V = 16384, SHM_K = 16384, SHM_R = 16384;
constexpr int NBUF = 3;
constexpr int LDS_BYTES = NBUF * (SHM_V + SHM_K + SHM_R) + NW * 64 * 4;
constexpr float SCALE = 0.07216878364870323f;
constexpr float THR = 8.f;
#define KSWZ(row, colB) ((row) * 256 + ((colB) ^ (((row) & 7) << 4)))
#define SBAR() __builtin_amdgcn_sched_barrier(0)
__device__ __forceinline__ int v_st(int k, int c) { const int kk = (k & ~0xC) | ((k & 4) << 1) | ((k & 8) >> 1); return ((kk >> 3) * 4 + (c >> 5)) * 512 + ((kk & 7) * 32 + (c & 31)) * 2; }
__device__ __forceinline__ int v_rd_base(int lane) { return ((lane & 3) << 3) | (((lane >> 2) & 3) << 6) | (((lane >> 4) & 1) << 5) | (((lane >> 5) & 1) << 8); }
constexpr int v_rd_off(int d0, int ks, int half) { return d0 * 512 + ks * 4096 + half * 2048; }
__device__ __forceinline__ int crow(int r, int hi) { return (r & 3) + 8 * (r >> 2) + 4 * hi; }
__device__ __forceinline__ bf16x8 load8(const bf16_t* p) { return *reinterpret_cast<const bf16x8*>(p); }
__device__ __forceinline__ void mask_tile(f32x16& p0, f32x16& p1, int dq) {
    const float NEG = -__builtin_inff();
#pragma unroll
    for (int r = 0; r < 16; ++r) { const int c = (r & 3) + 8 * (r >> 2); if (dq - c < 0) p0[r] = NEG; if (dq - c - 32 < 0) p1[r] = NEG; }
}
__device__ __forceinline__ void partialSM(f32x16& p0, f32x16& p1, float& m_reg, float& mn, float& alpha) {
    float pmax = p0[0];
#pragma unroll
    for (int r = 1; r < 16; ++r) pmax = fmaxf(pmax, p0[r]);
#pragma unroll
    for (int r = 0; r < 16; ++r) pmax = fmaxf(pmax, p1[r]);
    { auto rr = __builtin_amdgcn_permlane32_swap(__float_as_uint(pmax), __float_as_uint(pmax), false, false); pmax = fmaxf(__uint_as_float(rr[0]), __uint_as_float(rr[1])); }
    constexpr float C2 = 1.4426950408889634f * SCALE;
    if (__builtin_expect(__all((pmax - m_reg) * SCALE <= THR), 1)) { mn = m_reg; alpha = 1.f; }
    else { mn = fmaxf(m_reg, pmax); alpha = __builtin_amdgcn_exp2f((m_reg - mn) * C2); m_reg = mn; }
    const float mnL = -mn * C2;
#pragma unroll
    for (int r = 0; r < 16; ++r) p0[r] = fmaf(p0[r], C2, mnL);
#pragma unroll
    for (int r = 0; r < 16; ++r) p1[r] = fmaf(p1[r], C2, mnL);
#pragma unroll
    for (int r = 0; r < 16; ++r) p0[r] = __builtin_amdgcn_exp2f(p0[r]);
}
__device__ __forceinline__ void finishSM(f32x16& p0, f32x16& p1, float alpha, float& l_reg, bf16x8& pa0, bf16x8& pa1, bf16x8& pa2, bf16x8& pa3) {
#pragma unroll
    for (int r = 0; r < 16; ++r) p1[r] = __builtin_amdgcn_exp2f(p1[r]);
    float ps = 0;
#pragma unroll
    for (int r = 0; r < 16; ++r) ps += p0[r];
#pragma unroll
    for (int r = 0; r < 16; ++r) ps += p1[r];
    { auto rr = __builtin_amdgcn_permlane32_swap(__float_as_uint(ps), __float_as_uint(ps), false, false); ps = __uint_as_float(rr[0]) + __uint_as_float(rr[1]); }
    l_reg = l_reg * alpha + ps;
#define PK4(P, B_, OUT) do { unsigned a0 = cvt_pk(P[B_+0], P[B_+1]), a1 = cvt_pk(P[B_+2], P[B_+3]);                          \
        unsigned b0 = cvt_pk(P[B_+4], P[B_+5]), b1 = cvt_pk(P[B_+6], P[B_+7]);                                             \
        auto r0 = __builtin_amdgcn_permlane32_swap(a0, b0, false, false); auto r1 = __builtin_amdgcn_permlane32_swap(a1, b1, false, false); \
        u32x4 w = {r0[0], r1[0], r0[1], r1[1]}; OUT = *reinterpret_cast<bf16x8*>(&w); } while (0)
    PK4(p0, 0, pa0); PK4(p0, 8, pa1); PK4(p1, 0, pa2); PK4(p1, 8, pa3);
#undef PK4
}
__device__ __forceinline__ void qkt(f32x16& p0, f32x16& p1, const LAS char* Kb, int r32, int hi, const bf16x8* qr) {
    p0 = f32x16{}; p1 = f32x16{};
    const LAS char* kb[4];
#pragma unroll
    for (int dd = 0; dd < 4; ++dd) kb[dd] = Kb + KSWZ(r32, (dd * 16 + hi * 8) * 2);
#pragma unroll
    for (int d0 = 0; d0 < 12; ++d0) { const LAS char* a = kb[d0 & 3] + (d0 < 8 ? (d0 >> 2) * 128 : NBUF * SHM_K);
        if (d0 != 0 && (d0 & 1) == 0) SBAR();
        bf16x8 b0 = *reinterpret_cast<const LAS bf16x8*>(a);
        bf16x8 b1 = *reinterpret_cast<const LAS bf16x8*>(a + 32 * 256);
        p0 = __builtin_amdgcn_mfma_f32_32x32x16_bf16(b0, qr[d0], p0, 0, 0, 0);
        p1 = __builtin_amdgcn_mfma_f32_32x32x16_bf16(b1, qr[d0], p1, 0, 0, 0); }
}
__device__ __forceinline__ void pv_tile(f32x16* o, int vb0, bf16x8 pa0, bf16x8 pa1, bf16x8 pa2, bf16x8 pa3) {
#define TRRD(dst, off) asm volatile("ds_read_b64_tr_b16 %0, %1 offset:%2" : "=&v"(dst) : "v"(vb0), "i"(off) : "memory")
#define PV_D0(d0) do { s16x4 l0, l1, l2, l3, h0, h1, h2, h3; constexpr int b_ = v_rd_off(d0, 0, 0); \
        TRRD(l0, b_); TRRD(h0, b_ + 2048); TRRD(l1, b_ + 4096); TRRD(h1, b_ + 6144); TRRD(l2, b_ + 8192); TRRD(h2, b_ + 10240); TRRD(l3, b_ + 12288); TRRD(h3, b_ + 14336); \
        asm volatile("s_waitcnt lgkmcnt(0)" ::: "memory"); SBAR();   \
        o[d0] = __builtin_amdgcn_mfma_f32_32x32x16_bf16((bf16x8){l0[0], l0[1], l0[2], l0[3], h0[0], h0[1], h0[2], h0[3]}, pa0, o[d0], 0, 0, 0);   \
        o[d0] = __builtin_amdgcn_mfma_f32_32x32x16_bf16((bf16x8){l1[0], l1[1], l1[2], l1[3], h1[0], h1[1], h1[2], h1[3]}, pa1, o[d0], 0, 0, 0);   \
        o[d0] = __builtin_amdgcn_mfma_f32_32x32x16_bf16((bf16x8){l2[0], l2[1], l2[2], l2[3], h2[0], h2[1], h2[2], h2[3]}, pa2, o[d0], 0, 0, 0);   \
        o[d0] = __builtin_amdgcn_mfma_f32_32x32x16_bf16((bf16x8){l3[0], l3[1], l3[2], l3[3], h3[0], h3[1], h3[2], h3[3]}, pa3, o[d0], 0, 0, 0); } while (0)
    PV_D0(0); PV_D0(1); PV_D0(2); PV_D0(3);
#undef PV_D0
#undef TRRD
}
struct ARef { unsigned qoff, kvoff; bf16_t* O; int P0; int rev; };
struct Seam { bf16x8 qr[12]; int bt; };
struct Rsrc { __amdgpu_buffer_rsrc_t q, kv, r; };
__device__ __forceinline__ bf16x8 bload(__amdgpu_buffer_rsrc_t rs, unsigned voff, unsigned soff) { return __builtin_bit_cast(bf16x8, __builtin_amdgcn_raw_buffer_load_b128(rs, (int)voff, (int)soff, 0)); }
#define VMW() asm volatile("s_waitcnt vmcnt(0)" ::: "memory")
#define DMA_TILE(kvoff_, k0, bo) do { const int so_ = (int)((unsigned)(k0) * (KVW * 2) + (kvoff_)), sr2_ = (int)((unsigned)(k0) * (DR * 2));   \
        _Pragma("unroll") for (int j_ = 0; j_ < 2; ++j_) { const int pc_ = (bo) + (2 * wid + j_) * 1024;                                      \
            __builtin_amdgcn_raw_ptr_buffer_load_lds(RS.kv, (LAS void*)(K_lds + pc_), 16, voffK[j_], so_, 0, 0);                              \
            __builtin_amdgcn_raw_ptr_buffer_load_lds(RS.kv, (LAS void*)(V_lds + pc_), 16, voffV[j_], so_, 0, 0);                              \
            __builtin_amdgcn_raw_ptr_buffer_load_lds(RS.r, (LAS void*)(R_lds + pc_), 16, voffR[j_], sr2_, 0, 0); } } while (0)
#define DMA_OFFS int voffK[2], voffV[2], voffR[2];                                                                                             \
    _Pragma("unroll") for (int j_ = 0; j_ < 2; ++j_) { const int p_ = (2 * wid + j_) * 1024 + lane * 16;                                      \
        { const int row = p_ >> 8, pos = (p_ >> 4) & 15, lc = (pos & 8) | ((pos ^ row) & 7); voffK[j_] = row * (KVW * 2) + lc * 16; }            \
        { const int sub = p_ >> 9, kkh = sub >> 2, cblk = sub & 3, wi = p_ & 511, kkl = wi >> 6, cl = (wi & 63) >> 1, c = cblk * 32 + cl, kk = kkh * 8 + kkl, \
              k = (kk & ~0xC) | ((kk & 4) << 1) | ((kk & 8) >> 1); voffV[j_] = k * (KVW * 2) + (128 + c) * 2; }                                \
        { const int row = p_ >> 8, pos = (p_ >> 4) & 7, lc = (pos ^ row) & 7; voffR[j_] = row * (DR * 2) + lc * 16; } }
__device__ __forceinline__ void attn_prime(const ARef& cur, const Rsrc& RS, LAS char* lds, Seam& S) {
    const int tid = fresh_tid(), wid = __builtin_amdgcn_readfirstlane(tid >> 6), lane = tid & 63, r32 = lane & 31, hi = lane >> 5;
    const unsigned vq0 = (unsigned)((wid * QBLK + r32) * QW + hi * 8) * 2u;
    LAS char* V_lds = lds; LAS char* K_lds = lds + NBUF * SHM_V; LAS char* R_lds = lds + NBUF * (SHM_V + SHM_K);
    DMA_OFFS
#pragma unroll
    for (int d0 = 0; d0 < 12; ++d0) S.qr[d0] = bload(RS.q, vq0, cur.qoff + d0 * 32);
    DMA_TILE(cur.kvoff, (cur.rev ? (cur.P0 + QB) / KVBLK - 1 : 0) * KVBLK, 0); VMW(); S.bt = 0;
    __syncthreads();
}
__device__ __forceinline__ void attn_block(const ARef& cur, const ARef& nxt, const Rsrc& RS, LAS char* lds, Seam& S) {
    const int tid = fresh_tid(), wid = __builtin_amdgcn_readfirstlane(tid >> 6), lane = tid & 63, r32 = lane & 31, hi = lane >> 5;
    const int NT = (cur.P0 + QB) / KVBLK;
    const int qlo = cur.P0 + wid * QBLK, qm = qlo + r32 - 4 * hi;
    LAS char* V_lds = lds; LAS char* K_lds = lds + NBUF * SHM_V; LAS char* R_lds = lds + NBUF * (SHM_V + SHM_K);
    float m_reg = -1e30f, l_reg = 0; f32x16 o[4] = {};
    const unsigned vq0 = (unsigned)((wid * QBLK + r32) * QW + hi * 8) * 2u;
    DMA_OFFS
    const int vb0 = (int)(unsigned)(uintptr_t)V_lds + v_rd_base(lane);
    int bt = S.bt;
#define RESC(a) do { if (__any((a) < 1.f)) { _Pragma("unroll") for (int d_ = 0; d_ < 4; ++d_) o[d_] = o[d_] * (a); } } while (0)
#define MASKT(P0_, P1_, t) do { const int kb_ = (t) * KVBLK; if (kb_ + KVBLK - 1 > qlo) mask_tile(P0_, P1_, qm - kb_); } while (0)
#define TILE_OF(t) (rev ? NT - 1 - (t) : (t))
#define STAGE_NEXT(t, bo) do { if ((t) + 1 < NT) { DMA_TILE(cur.kvoff, TILE_OF((t) + 1) * KVBLK, bo); } else { DMA_TILE(nxt.kvoff, nxt_first * KVBLK, bo); } } while (0)
#define QNEXT(t) do { if ((t) + 1 >= NT) { _Pragma("unroll") for (int d0 = 0; d0 < 12; ++d0) S.qr[d0] = bload(RS.q, vq0, nxt.qoff + d0 * 32); } } while (0)
    const bool lag = wid >= 4;
    const int rev = cur.rev, nxt_first = nxt.rev ? (nxt.P0 + QB) / KVBLK - 1 : 0;
    f32x16 p0, p1; float mn, al; bf16x8 pa0, pa1, pa2, pa3;
#define STEP(t, FIRST) do { const int bn = bt == NBUF - 1 ? 0 : bt + 1, bp = bt == 0 ? NBUF - 1 : bt - 1;                              \
        SBAR();                                                                                                              \
        if (lag && !(FIRST)) { pv_tile(o, vb0 + bp * SHM_V, pa0, pa1, pa2, pa3); SBAR(); }                                   \
        qkt(p0, p1, K_lds + bt * SHM_K, r32, hi, S.qr); SBAR();                                                             \
        STAGE_NEXT(t, bn * SHM_V); SBAR();     \
        QNEXT(t); SBAR();                                                                                                    \
        MASKT(p0, p1, TILE_OF(t)); partialSM(p0, p1, m_reg, mn, al); if (!(FIRST)) RESC(al);                               \
        finishSM(p0, p1, al, l_reg, pa0, pa1, pa2, pa3); SBAR();                                                             \
        if (!lag) { pv_tile(o, vb0 + bt * SHM_V, pa0, pa1, pa2, pa3); SBAR(); }                                              \
        VMW(); __syncthreads(); bt = bn; } while (0)
    STEP(0, true);
#pragma unroll 1
    for (int t = 1; t < NT; ++t) STEP(t, false);
    if (lag) { const int bp = bt == 0 ? NBUF - 1 : bt - 1; pv_tile(o, vb0 + bp * SHM_V, pa0, pa1, pa2, pa3); SBAR(); }
#undef STEP
    S.bt = bt;
    {
        const float inv = __builtin_amdgcn_rcpf(l_reg);
        bf16_t* Orow = cur.O + (size_t)(wid * QBLK + r32) * DM + (hi ? 8 : 0);
#pragma unroll
        for (int d0 = 0; d0 < 4; ++d0)
#pragma unroll
            for (int gp = 0; gp < 2; ++gp) { const int ra = 8 * gp, rb = 8 * gp + 4;
                unsigned ax = cvt_pk(o[d0][ra] * inv, o[d0][ra + 1] * inv), ay = cvt_pk(o[d0][ra + 2] * inv, o[d0][ra + 3] * inv);
                unsigned bx = cvt_pk(o[d0][rb] * inv, o[d0][rb + 1] * inv), by = cvt_pk(o[d0][rb + 2] * inv, o[d0][rb + 3] * inv);
                auto sx = __builtin_amdgcn_permlane32_swap(ax, bx, false, false); auto sy = __builtin_amdgcn_permlane32_swap(ay, by, false, false);
                u32x4 w = {sx[0], sy[0], sx[1], sy[1]};
                *(u32x4*)(Orow + d0 * 32 + 16 * gp) = w; }
    }
#undef RESC
#undef MASKT
#undef STAGE_NEXT
#undef TILE_OF
#undef QNEXT
}
#undef VMW
__device__ __forceinline__ ARef make_ref(int L, int pass, bf16_t* O) {
    const int h = L >> 5, x = L & 31, qb = pass ? x : 63 - x;
    ARef r; r.qoff = (unsigned)(qb * QB * QW + h * DQK) * 2u; r.kvoff = (unsigned)(h * 256) * 2u; r.O = O + (size_t)qb * QB * DM + h * DV; r.P0 = qb * QB; r.rev = pass;
    return r;
}
__device__ __forceinline__ void attn_phase(LAS char* lds, const bf16_t* Q, const bf16_t* KV, const bf16_t* KPE, bf16_t* O, int vcu, int G) {
    constexpr int TOTAL = 512;
    int L = vcu; if (L >= TOTAL) return;
    int pass = 0;
    Rsrc RS; RS.q = __builtin_amdgcn_make_buffer_rsrc((void*)Q, 0, 0x7fffffff, 0x00020000); RS.kv = __builtin_amdgcn_make_buffer_rsrc((void*)KV, 0, 0x7fffffff, 0x00020000); RS.r = __builtin_amdgcn_make_buffer_rsrc((void*)KPE, 0, 0x7fffffff, 0x00020000);
    ARef cur = make_ref(L, 0, O);
    Seam S;
    if (__builtin_amdgcn_readfirstlane((int)threadIdx.x >> 6) < 4) __builtin_amdgcn_s_setprio(2); else __builtin_amdgcn_s_setprio(0);
    attn_prime(cur, RS, lds, S);
    for (;;) {
        const bool more_pass = pass == 0, more_item = L + G < TOTAL, last = !more_pass && !more_item;
        int passn = pass + 1, Ln = L;
        if (!more_pass) { passn = 0; Ln = more_item ? L + G : L; }
        const ARef nxt = last ? cur : make_ref(Ln, passn, O);
        attn_block(cur, nxt, RS, lds, S);
        if (last) { __builtin_amdgcn_s_setprio(0); break; }
        cur = nxt; pass = passn; L = Ln;
    }
}
#undef KSWZ
#undef SBAR
}

struct Args { const void* in[27]; float* out; unsigned char* ws; float inv_freq[32]; };

template <class Map>
__device__ __forceinline__ void transpose_item(const float* W, int K, int N, bf16_t* WT, int nblk, LAS float* scr, int item, int lane, Map map, const float* kscale, const float* nscale) {
    const int kb = item / nblk, nb = item % nblk, k0 = 64 * kb, n0 = 32 * nb;
    const int src = map(n0 + (lane & 31));
    const float ns = (src >= 0 && nscale) ? nscale[src] : 1.f;
#pragma unroll 8
    for (int i = 0; i < 32; ++i) { const int kk = 2 * i + (lane >> 5); float v = src >= 0 ? __builtin_nontemporal_load(&W[(size_t)(k0 + kk) * N + src]) : 0.f;     v *= ns; if (kscale) v *= kscale[k0 + kk]; scr[kk * 33 + (lane & 31)] = v; }
    LDS_WAIT(); asm volatile("" ::: "memory");
    const int c = lane & 7;
#pragma unroll
    for (int j = 0; j < 4; ++j) { const int n = (lane >> 3) + 8 * j; const LAS float* s = scr + (8 * c) * 33 + n;
        u32x4 o; o.x = cvt_pk(s[0 * 33], s[1 * 33]); o.y = cvt_pk(s[2 * 33], s[3 * 33]); o.z = cvt_pk(s[4 * 33], s[5 * 33]); o.w = cvt_pk(s[6 * 33], s[7 * 33]);
        *(u32x4*)(WT + (size_t)(n0 + n) * K + k0 + 8 * c) = o; }
    LDS_WAIT(); asm volatile("" ::: "memory");
}
struct MapId { __device__ __forceinline__ int operator()(int n) const { return n; } };
struct MapIn { __device__ __forceinline__ int operator()(int n) const { if (n < 1024) return n; if (n < 1280) { const int j = n - 1024; if (j >= 64) return -1; return 1024 + ((j & 1) ? 32 + (j >> 1) : (j >> 1)); } return n - 1280 + 1088; } };
struct MapQ { __device__ __forceinline__ int operator()(int n) const { if (n < 2048) return (n >> 7) * DQK + (n & 127); const int j = n - 2048, head = j >> 6, jj = j & 63, i = jj >> 1; return head * DQK + DN + ((jj & 1) ? i + 32 : i); } };
struct MapFfn { __device__ __forceinline__ int operator()(int n) const { const int tile = n >> 8, r = n & 255, ch = 128 * tile + (r & 127); return r < 128 ? ch : DFF + ch; } };

__device__ __forceinline__ void rms_row_bf16(const float* xrow, const float* g, bf16_t* orow, int lane) {
    f32x4 v[8]; float s = 0.f;
#pragma unroll
    for (int j = 0; j < 8; ++j) { v[j] = *(const f32x4*)(xrow + 4 * lane + 256 * j); s += (v[j][0] * v[j][0] + v[j][1] * v[j][1]) + (v[j][2] * v[j][2] + v[j][3] * v[j][3]); }
    const float rstd = 1.0f / sqrtf(wave_sum(s) * (1.0f / DM) + EPS);
#pragma unroll
    for (int j = 0; j < 8; ++j) { const f32x4 gg = *(const f32x4*)(g + 4 * lane + 256 * j); const f32x4 y = v[j] * rstd * gg;
        u32x2 w; w.x = cvt_pk(y[0], y[1]); w.y = cvt_pk(y[2], y[3]); *(u32x2*)(orow + 4 * lane + 256 * j) = w; }
}
template <bool SECOND>
__device__ __forceinline__ void resid_row(const float* xi, const bf16_t* mo, const float* stat, const float* gpost, float* xo, const float* gpre, bf16_t* hrow, int lane) {
    const float st = stat[lane & 31]; float ss = st;
#pragma unroll
    for (int o = 1; o < 32; o <<= 1) ss += __shfl_xor(ss, o);
    const float rstd = 1.0f / sqrtf(ss * (1.0f / DM) + EPS);
    f32x4 v[8]; float s = 0.f;
#pragma unroll
    for (int j = 0; j < 8; ++j) { const int c = 4 * lane + 256 * j; const u32x2 mw = __builtin_nontemporal_load((const u32x2*)(mo + c)); const f32x4 a = __builtin_nontemporal_load((const f32x4*)(xi + c)),     b = (f32x4){bf_lo(mw.x), bf_hi(mw.x), bf_lo(mw.y), bf_hi(mw.y)}, gg = *(const f32x4*)(gpost + c);
        v[j] = a + b * rstd * gg; s += (v[j][0] * v[j][0] + v[j][1] * v[j][1]) + (v[j][2] * v[j][2] + v[j][3] * v[j][3]); *(f32x4*)(xo + c) = v[j]; }
    if (SECOND) { const float r2 = 1.0f / sqrtf(wave_sum(s) * (1.0f / DM) + EPS);
#pragma unroll
        for (int j = 0; j < 8; ++j) { const int c = 4 * lane + 256 * j; const f32x4 gg = *(const f32x4*)(gpre + c); const f32x4 y = v[j] * r2 * gg;
            u32x2 w; w.x = cvt_pk(y[0], y[1]); w.y = cvt_pk(y[2], y[3]); *(u32x2*)(hrow + c) = w; } }
}

#define W_IN ((bf16_t*)(ws + WS_W_IN))
#define W_QB ((bf16_t*)(ws + WS_W_QB))
#define W_KVB ((bf16_t*)(ws + WS_W_KVB))
#define W_ATT ((bf16_t*)(ws + WS_W_ATT))
#define W_PG ((bf16_t*)(ws + WS_W_PG))
#define W_PBR ((bf16_t*)(ws + WS_W_PBR))
#define W_MIX ((bf16_t*)(ws + WS_W_MIX))
#define W_MQ ((bf16_t*)(ws + WS_W_MQ))
#define W_MKV ((bf16_t*)(ws + WS_W_MKV))
#define W_MO ((bf16_t*)(ws + WS_W_MO))
#define W_FIN ((bf16_t*)(ws + WS_W_FIN))
#define W_FOUT ((bf16_t*)(ws + WS_W_FOUT))
#define ROPE ((f32x2*)(ws + WS_ROPE))
#define STAT ((float*)(ws + WS_STAT))
#define KPE ((bf16_t*)(ws + WS_KPE))
#define MEMN ((bf16_t*)(ws + WS_MEMN))
#define MEMKV ((bf16_t*)(ws + WS_MEMK))
#define WKT ((bf16_t*)(ws + 452 * MiB))
#define VWT ((bf16_t*)(ws + 448 * MiB))
#define H3 ((bf16_t*)(ws + WS_H3))
#define QC ((bf16_t*)(ws + WS_QC))
#define U ((bf16_t*)(ws + WS_U))
#define GA ((bf16_t*)(ws + WS_GA))
#define GP ((bf16_t*)(ws + WS_GP))
#define D ((bf16_t*)(dob + DO_PD))
#define W_PCT ((bf16_t*)(ws + 4 * MiB))
#define KV ((bf16_t*)(ws + WS_KV))
#define AO ((bf16_t*)(ws + WS_AO))
#define MERGED ((bf16_t*)(ws + WS_MERGED))
#define MO ((bf16_t*)(ws + WS_MO))
#define H2 ((bf16_t*)(ws + WS_H2))
#define QM ((bf16_t*)(ws + WS_QM))
#define PM ((bf16_t*)(ws + WS_PM))
#define OM ((bf16_t*)(ws + WS_OM))
#define MO2 ((bf16_t*)(ws + WS_MO2))
#define AH ((bf16_t*)(ws + WS_AH))
#define ACT ((bf16_t*)(ws + WS_ACT))
#define MO3 ((bf16_t*)(ws + WS_MO3))
#define H ((bf16_t*)(dob + DO_H))
#define Q ((bf16_t*)(dob + DO_Q))


#define XB_TMO      128
#define XB_XCNT(j)  (256  + 64 * (j))
#define XB_XSUB(j)  (1280 + 64 * (j))
#define XB_XGEN(j)  (2304 + 64 * (j))
#define XB_TOP      3328
#define XB_TOPGEN   3392
#define XCD_BAR_WORDS 3456
#define XB_SPIN_CAP (1u << 20)
__device__ unsigned g_bar[XCD_BAR_WORDS];
__device__ __forceinline__ unsigned xb_ld(unsigned* p)              { return __hip_atomic_load(p, __ATOMIC_RELAXED, __HIP_MEMORY_SCOPE_AGENT); }
__device__ __forceinline__ unsigned xb_add(unsigned* p, unsigned v) { return __hip_atomic_fetch_add(p, v, __ATOMIC_RELAXED, __HIP_MEMORY_SCOPE_AGENT); }
__device__ __forceinline__ unsigned xb_xcc_id() { return (unsigned)__builtin_amdgcn_s_getreg((3 << 11) | 20) & 0xFu; }
#define XB_SPIN(cond, bar) do { unsigned _sp = 0; while (cond) { __builtin_amdgcn_s_sleep(1); \
    if ((++_sp & 255u) == 0u) { if (xb_ld(&(bar)[XB_TMO])) break; if (_sp > XB_SPIN_CAP) { atomicAdd(&(bar)[XB_TMO], 1u); break; } } } } while (0)
struct XcdBarrier { unsigned* bar; unsigned x; volatile LAS unsigned* st; };
__device__ __forceinline__ XcdBarrier xcd_barrier_post(unsigned* bar, volatile LAS unsigned* st) {
    XcdBarrier b; b.bar = bar; b.x = xb_xcc_id(); b.st = st;
    if (threadIdx.x == 0) (void)xb_add(&bar[XB_XCNT(b.x)], 1u);
    return b;
}
__device__ __forceinline__ void xcd_barrier_complete(unsigned* bar, unsigned x, unsigned& nloc, unsigned& nx) {
    const unsigned G = gridDim.x * gridDim.y * gridDim.z;
    unsigned sum, cnt, mine, sp = 0u;
    for (;;) {
        sum = 0u; cnt = 0u; mine = 0u;
#pragma unroll
        for (unsigned j = 0; j < 16; ++j) { const unsigned c = xb_ld(&bar[XB_XCNT(j)]); sum += c; cnt += (c > 0u) ? 1u : 0u; mine = (j == x) ? c : mine; }
        if (sum == G) break;
        __builtin_amdgcn_s_sleep(1);
        if ((++sp & 255u) == 0u) { if (xb_ld(&bar[XB_TMO])) break; if (sp > XB_SPIN_CAP) { atomicAdd(&bar[XB_TMO], 1u); break; } }
    }
    nloc = mine > 0u ? mine : 1u; nx = cnt > 0u ? cnt : 1u;
}
__device__ __forceinline__ void xcd_barrier(const XcdBarrier& b) {
    asm volatile("s_waitcnt vmcnt(0)" ::: "memory");
    __syncthreads();
    if (threadIdx.x == 0) {
        unsigned* bar = b.bar;
        __builtin_amdgcn_s_waitcnt(0);
        unsigned nloc = b.st[0], nx = b.st[1];
        if (nloc == 0u) { xcd_barrier_complete(bar, b.x, nloc, nx); b.st[0] = nloc; b.st[1] = nx; }
        const unsigned old = xb_add(&bar[XB_XSUB(b.x)], 1u);
        const unsigned gen = old / nloc;
        if (old + 1u == (gen + 1u) * nloc) {
            __builtin_amdgcn_fence(__ATOMIC_RELEASE, "agent");
            asm volatile("s_waitcnt vmcnt(0)" ::: "memory");
            const unsigned og = xb_add(&bar[XB_TOP], 1u);
            const unsigned tg = og / nx;
            if (og + 1u == (tg + 1u) * nx) xb_add(&bar[XB_TOPGEN], 1u);
            else XB_SPIN(xb_ld(&bar[XB_TOPGEN]) == tg, bar);
            __builtin_amdgcn_fence(__ATOMIC_ACQUIRE, "agent");
            xb_add(&bar[XB_XGEN(b.x)], 1u);
            asm volatile("s_waitcnt vmcnt(0)" ::: "memory");
        } else {
            XB_SPIN(xb_ld(&bar[XB_XGEN(b.x)]) == gen, bar);
            __builtin_amdgcn_fence(__ATOMIC_ACQUIRE, "agent");
            asm volatile("s_waitcnt vmcnt(0)" ::: "memory");
        }
    }
    __syncthreads();
}
__global__ void __launch_bounds__(NTHREADS) fwd_megakernel(Args a) {
    extern __shared__ __attribute__((aligned(16))) unsigned char lds_raw[];
    cg::grid_group grid = cg::this_grid();
    LAS unsigned char* lds = (LAS unsigned char*)lds_raw;
    const int G = gridDim.x, bid = blockIdx.x;
    if (bid == 0) for (int u_ = threadIdx.x; u_ < XCD_BAR_WORDS; u_ += NTHREADS) g_bar[u_] = 0u;
    volatile LAS unsigned* bar_st = (volatile LAS unsigned*)(lds + (152 * 1024 - 64));
    if (threadIdx.x < 2) bar_st[threadIdx.x] = 0u;
    __syncthreads();
    const int vcu = (G % 8 == 0) ? (bid % 8) * (G / 8) + bid / 8 : bid;
    const int NGW = G * NWAVES, NGT = G * NTHREADS;
#define PHASE_IDS const int tid = fresh_tid(), lane = tid & 63, wave = __builtin_amdgcn_readfirstlane(tid >> 6), gw = bid * NWAVES + wave, gt = bid * NTHREADS + tid; (void)lane; (void)gw; (void)gt;
    unsigned char* ws = a.ws; unsigned char* dob = (unsigned char*)a.out;
    const float* x = (const float*)a.in[0];
#ifndef ATT_ONLY
    {
        PHASE_IDS
        LAS float* scr = (LAS float*)(lds + wave * 8704);
        const float* w_in = (const float*)a.in[4]; const float* g_q_a = (const float*)a.in[5]; const float* w_q_b = (const float*)a.in[6]; const float* g_kv_a = (const float*)a.in[7];
        const float* w_kv_b = (const float*)a.in[8]; const float* w_attn_br = (const float*)a.in[9]; const float* w_pool_grp = (const float*)a.in[10]; const float* pool_scale = (const float*)a.in[11];
        const float* w_pool_br = (const float*)a.in[12]; const float* w_mix_out = (const float*)a.in[13]; const float* w_mem_q = (const float*)a.in[17]; const float* w_mem_kv = (const float*)a.in[18];
        const float* w_mem_o = (const float*)a.in[19]; const float* w_ffn_in = (const float*)a.in[22]; const float* w_ffn_out = (const float*)a.in[25];
        constexpr int I_IN = 32 * (DINP / 32), I_QB = 8 * (QW / 32), I_KVB = 8 * (KVW / 32), I_SQ = 32 * 64, I_PG = 256, I_PBR = 16 * 64, I_MKV = 32 * 128, I_FIN = 32 * (FF2 / 32), I_FOUT = 88 * 64;
        constexpr int NITEMS = I_IN + I_QB + I_KVB + I_SQ + 4 * I_PG + I_PBR + I_SQ + I_SQ + I_MKV + I_SQ + I_FIN + I_FOUT;
        for (int it = gw; it < NITEMS; it += NGW) {
            int r = it;
            if (r < I_IN) { transpose_item(w_in, DM, DIN, W_IN, DINP / 32, scr, r, lane, MapIn(), nullptr, nullptr); continue; } r -= I_IN;
            if (r < I_QB) { transpose_item(w_q_b, QL, QW, W_QB, QW / 32, scr, r, lane, MapQ(), g_q_a, nullptr); continue; } r -= I_QB;
            if (r < I_KVB) { transpose_item(w_kv_b, QL, KVW, W_KVB, KVW / 32, scr, r, lane, MapId(), g_kv_a, nullptr); continue; } r -= I_KVB;
            if (r < I_SQ) { transpose_item(w_attn_br, DM, DM, W_ATT, 64, scr, r, lane, MapId(), nullptr, nullptr); continue; } r -= I_SQ;
            if (r < 4 * I_PG) {
                const f32x4 v = *(const f32x4*)(w_pool_grp + (size_t)r * 256 + 4 * lane) * *(const f32x4*)(pool_scale + (r >> 8) * 256 + 4 * lane);
                u32x2 w; w.x = cvt_pk(v[0], v[1]); w.y = cvt_pk(v[2], v[3]); *(u32x2*)(W_PG + (size_t)r * 256 + 4 * lane) = w; continue; } r -= 4 * I_PG;
            if (r < I_PBR) { transpose_item(w_pool_br, PW, DM, W_PBR, 64, scr, r, lane, MapId(), nullptr, nullptr); continue; } r -= I_PBR;
            if (r < I_SQ) { transpose_item(w_mix_out, DM, DM, W_MIX, 64, scr, r, lane, MapId(), nullptr, nullptr); continue; } r -= I_SQ;
            if (r < I_SQ) {
#pragma unroll
                for (int j = 0; j < 8; ++j) { const f32x4 v = __builtin_nontemporal_load((const f32x4*)(w_mem_q + (size_t)r * DM + 4 * lane + 256 * j)); u32x2 w; w.x = cvt_pk(v[0], v[1]); w.y = cvt_pk(v[2], v[3]); *(u32x2*)(W_MQ + (size_t)r * DM + 4 * lane + 256 * j) = w; }
                continue; } r -= I_SQ;
            if (r < I_MKV) { transpose_item(w_mem_kv, DM, 4096, W_MKV, 128, scr, r, lane, MapId(), nullptr, nullptr); continue; } r -= I_MKV;
            if (r < I_SQ) { transpose_item(w_mem_o, DM, DM, W_MO, 64, scr, r, lane, MapId(), nullptr, nullptr); continue; } r -= I_SQ;
            if (r < I_FIN) { transpose_item(w_ffn_in, DM, FF2, W_FIN, FF2 / 32, scr, r, lane, MapFfn(), nullptr, nullptr); continue; } r -= I_FIN;
            transpose_item(w_ffn_out, DFF, DM, W_FOUT, 64, scr, r, lane, MapId(), nullptr, nullptr);
        }
        const float* g_mix_pre = (const float*)a.in[3]; const float* mem = (const float*)a.in[1]; const float* g_mem_kv = (const float*)a.in[16];
        for (int m = gw; m < S_; m += NGW) rms_row_bf16(x + (size_t)m * DM, g_mix_pre, H + (size_t)m * DM, lane);
        for (int m = gw; m < NMEM; m += NGW) rms_row_bf16(mem + (size_t)m * DM, g_mem_kv, MEMN + (size_t)m * DM, lane);
        const int* pos = (const int*)a.in[2];
        for (int e = gt; e < S_ * 32; e += NGT) { const int row = e >> 5, i = e & 31; const float ang = (float)pos[row] * a.inv_freq[i];
            double rev = (double)ang * 0.15915494309189535; rev -= floor(rev); const float rf = (float)rev;
            ROPE[e] = (f32x2){__builtin_amdgcn_cosf(rf), __builtin_amdgcn_sinf(rf)}; }
    }
    grid.sync();
    const XcdBarrier xbar = xcd_barrier_post(g_bar, bar_st);

    { pg8::Gemm g{H, W_IN, DM, DM, DM}; pg8::Order S; S.init(64, 25, G, bid, 0); EpiIn E{QC, U, GA, GP, KPE, STAT, ROPE}; pg8::gemm_phase<EpiIn, false, true>(lds, g, S, E); }
    xcd_barrier(xbar);

    {
        PHASE_IDS
        for (int it = gt; it < 128 * 1024; it += NGT) { const int cgp = it & 127, chunk = it >> 7, t0 = chunk * 16, c = cgp * 8, w = 2 << (cgp >> 5);
            float sum[8];
#pragma unroll
            for (int e = 0; e < 8; ++e) sum[e] = 0.f;
            for (int k = 1; k < w; ++k) { const int t = t0 - k; if (t >= 0) { f32x4 p, q; unpack8(*(const u32x4*)(U + (size_t)t * PW + c), p, q);
#pragma unroll
                for (int e = 0; e < 4; ++e) { sum[e] += p[e]; sum[4 + e] += q[e]; } } }
            for (int r = 0; r < 16; ++r) { const int t = t0 + r; f32x4 p, q; unpack8(*(const u32x4*)(U + (size_t)t * PW + c), p, q);
#pragma unroll
                for (int e = 0; e < 4; ++e) { sum[e] += p[e]; sum[4 + e] += q[e]; }
                const float ic = 1.0f / (float)(t + 1 < w ? t + 1 : w); f32x4 d0, d1;
#pragma unroll
                for (int e = 0; e < 4; ++e) { d0[e] = sum[e] * ic - p[e]; d1[e] = sum[4 + e] * ic - q[e]; }
                *(u32x4*)(D + (size_t)t * PW + c) = pack8(d0, d1);
                const int tt = t - w + 1; if (tt >= 0) { f32x4 p2, q2; unpack8(*(const u32x4*)(U + (size_t)tt * PW + c), p2, q2);
#pragma unroll
                    for (int e = 0; e < 4; ++e) { sum[e] -= p2[e]; sum[4 + e] -= q2[e]; } } } }
        { pg8::Gemm g{QC, W_QB, 1024, QL, QL}; pg8::Order S; S.init(64, 12, G, bid, 0); EpiQ E{Q, STAT, ROPE}; pg8::gemm_phase(lds, g, S, E); }
        { pg8::Gemm g{QC + 512, W_KVB, 1024, QL, QL}; pg8::Order S; S.init(64, 16, G, bid, 0); EpiKV E{KV, STAT}; pg8::gemm_phase(lds, g, S, E); }
        { pg8::Gemm g{MEMN, W_MKV, DM, DM, DM}; pg8::Order S; S.init(1, 16, G, bid, 0); EpiStore E{MEMKV, 4096, 0}; pg8::gemm_phase(lds, g, S, E); }
#pragma unroll 1
        for (int gi = 0; gi < 4; ++gi) { pg8::Gemm g{W_PBR + gi * 256, W_PG + gi * 65536, PW, 256, 256}; pg8::Order S; S.init(8, 1, G, bid, 16 + gi * 8); EpiStore E{W_PCT, PW, gi * 256}; pg8::gemm_phase(lds, g, S, E); }
    }
    xcd_barrier(xbar);

#endif
    {
#ifndef ATT_ONLY
#endif
#ifndef NO_ATT
        att::attn_phase((LAS char*)lds, Q, KV, KPE, AO, vcu, G);
#endif
    }
    xcd_barrier(xbar);

#ifndef ATT_ONLY
    { pg8::Gemm g{AO, W_ATT, DM, DM, DM}; pg8::Order S; S.init(64, 8, G, bid, 0); EpiMerge<0> E{MERGED, GA}; pg8::gemm_phase(lds, g, S, E); }
    { pg8::Gemm g{D, W_PCT, PW, PW, PW}; pg8::Order S; S.init(64, 8, G, bid, 0); EpiMerge<1> E{MERGED, GP}; pg8::gemm_phase(lds, g, S, E); }
    xcd_barrier(xbar);

    { pg8::Gemm g{MERGED, W_MIX, DM, DM, DM}; pg8::Order S; S.init(64, 8, G, bid, 0); EpiF32Stat E{MO, STAT}; pg8::gemm_phase(lds, g, S, E); }
    xcd_barrier(xbar);

#pragma unroll 1
    for (int h = 0; h < 4; ++h) { pg8::Gemm g{W_MO + h * MHD, MEMKV + 2048 + h * MHD, DM, 4096, MHD}; pg8::Order S; S.init(8, 1, G, bid, h * 8); EpiStore E{VWT, 1024, h * 256}; pg8::gemm_phase(lds, g, S, E); }
#pragma unroll 1
    for (int h = 0; h < 4; ++h) { pg8::Gemm g{MEMKV + h * MHD, W_MQ + h * MHD, 4096, DM, MHD}; pg8::Order S; S.init(1, 8, G, bid, 32 + h * 8); EpiStore E{WKT + (size_t)h * 256 * DM, DM, 0}; pg8::gemm_phase(lds, g, S, E); }
    { PHASE_IDS for (int m = gw; m < S_; m += NGW) resid_row<true>(x + (size_t)m * DM, MO + (size_t)m * DM, STAT + (size_t)m * 32, (const float*)a.in[14], a.out + (size_t)m * DM, (const float*)a.in[15], H2 + (size_t)m * DM, lane); }
    xcd_barrier(xbar);

#pragma unroll 1
    for (int h = 0; h < 4; ++h) { pg8::Gemm g{H2, WKT + (size_t)h * 256 * DM, DM, DM, DM}; pg8::Order S; S.init(64, 1, G, bid, h * 64); EpiSoftmax E{PM, h * 256, (LAS f32x2*)(lds + pg8::STAGE_BYTES)}; pg8::gemm_phase(lds, g, S, E); }
    xcd_barrier(xbar);

    { pg8::Gemm g{PM, VWT, 1024, 1024, 1024}; pg8::Order S; S.init(64, 8, G, bid, 0); EpiF32Stat E{MO2, STAT}; pg8::gemm_phase(lds, g, S, E); }
    xcd_barrier(xbar);

    { PHASE_IDS for (int m = gw; m < S_; m += NGW) resid_row<true>(a.out + (size_t)m * DM, MO2 + (size_t)m * DM, STAT + (size_t)m * 32, (const float*)a.in[20], a.out + (size_t)m * DM, (const float*)a.in[21], H3 + (size_t)m * DM, lane); }
    xcd_barrier(xbar);

    { pg8::Gemm g{H3, W_FIN, DM, DM, DM}; pg8::Order S; S.init(64, 44, G, bid, 0); EpiFfn E{ACT, (float*)(ws + WS_AH), (const float*)a.in[23], (const float*)a.in[24], (LAS float*)(lds + pg8::STAGE_BYTES)}; pg8::gemm_phase<EpiFfn, true>(lds, g, S, E); }
    xcd_barrier(xbar);
    {
        PHASE_IDS
        const float* conv_w = (const float*)a.in[23]; const float* conv_b = (const float*)a.in[24]; const float* HALO = (const float*)(ws + WS_AH);
        for (int it = gt; it < 63 * 2 * 704; it += NGT) { const int cg8 = it % 704, rr = (it / 704) & 1, pm = 1 + it / 1408, tile = cg8 >> 4, c = (cg8 & 15) * 8, ch = tile * 128 + c, gcol = tile * 256 + c;
            const float* r0 = HALO + ((size_t)pm * 4 + rr) * FF2; const float* r1 = rr ? HALO + ((size_t)pm * 4 + 0) * FF2 : HALO + ((size_t)(pm - 1) * 4 + 3) * FF2; const float* r2 = rr ? HALO + ((size_t)(pm - 1) * 4 + 3) * FF2 : HALO + ((size_t)(pm - 1) * 4 + 2) * FF2;
            f32x4 o[2];
#pragma unroll
            for (int q = 0; q < 2; ++q) { const int cc = gcol + 4 * q, jj = ch + 4 * q;
                const f32x4 cgv = *(const f32x4*)(conv_b + jj) + *(const f32x4*)(conv_w + jj) * *(const f32x4*)(r2 + cc) + *(const f32x4*)(conv_w + FF2 + jj) * *(const f32x4*)(r1 + cc) + *(const f32x4*)(conv_w + 2 * (size_t)FF2 + jj) * *(const f32x4*)(r0 + cc);
                const f32x4 cuv = *(const f32x4*)(conv_b + DFF + jj) + *(const f32x4*)(conv_w + DFF + jj) * *(const f32x4*)(r2 + cc + 128) + *(const f32x4*)(conv_w + FF2 + DFF + jj) * *(const f32x4*)(r1 + cc + 128) + *(const f32x4*)(conv_w + 2 * (size_t)FF2 + DFF + jj) * *(const f32x4*)(r0 + cc + 128);
#pragma unroll
                for (int e = 0; e < 4; ++e) o[q][e] = gelu_tanh(cgv[e]) * cuv[e]; }
            *(u32x4*)(ACT + (size_t)(pm * 256 + rr) * DFF + ch) = pack8(o[0], o[1]); }
    }
    xcd_barrier(xbar);
    { pg8::Gemm g{ACT, W_FOUT, DFF, DFF, DFF}; pg8::Order S; S.init(64, 8, G, bid, 0); EpiF32Stat E{MO3, STAT}; pg8::gemm_phase(lds, g, S, E); }
    xcd_barrier(xbar);

    { PHASE_IDS for (int m = gw; m < S_; m += NGW) resid_row<false>(a.out + (size_t)m * DM, MO3 + (size_t)m * DM, STAT + (size_t)m * 32, (const float*)a.in[26], a.out + (size_t)m * DM, nullptr, nullptr, lane); }
#endif
}

constexpr int LDS_BYTES = 152 * 1024;
static_assert(att::LDS_BYTES <= LDS_BYTES - 64 && pg8::STAGE_BYTES + 8192 <= LDS_BYTES - 64, "LDS map");
extern "C" void kernel_launch(void* const* d_in, const int* in_sizes, int n_in, void* d_out, int out_size, void* d_ws, size_t ws_size, hipStream_t stream) {
    static int grid = 0;
    if (grid == 0) {
        if (n_in != 27 || in_sizes[0] != S_ * DM || out_size != S_ * DM || ws_size < WS_END) { fprintf(stderr, "kernel_launch: unexpected shapes (n_in %d, in0 %d, out %d, ws %zu)\n", n_in, n_in > 0 ? in_sizes[0] : -1, out_size, ws_size); grid = -1; return; }
        int dev = 0, cus = 0, per_cu = 0;
        (void)hipGetDevice(&dev); (void)hipDeviceGetAttribute(&cus, hipDeviceAttributeMultiprocessorCount, dev);
        if (hipFuncSetAttribute((const void*)fwd_megakernel, hipFuncAttributeMaxDynamicSharedMemorySize, LDS_BYTES) != hipSuccess) { fprintf(stderr, "kernel_launch: hipFuncSetAttribute failed\n"); grid = -1; return; }
        if (hipOccupancyMaxActiveBlocksPerMultiprocessor(&per_cu, (const void*)fwd_megakernel, NTHREADS, LDS_BYTES) != hipSuccess || per_cu < 1) { fprintf(stderr, "kernel_launch: occupancy query gave %d\n", per_cu); per_cu = 1; }
        (void)hipGetLastError();
        if (cus <= 0) cus = 256;
        grid = cus * (per_cu > 1 ? 1 : per_cu);
    }
    if (grid < 0) return;
    Args a{};
    for (int i = 0; i < 27; ++i) a.in[i] = d_in[i];
    a.out = (float*)d_out; a.ws = (unsigned char*)d_ws;
    for (int i = 0; i < 32; ++i) a.inv_freq[i] = (float)pow(10000.0, -(double)i / 32.0);
    void* args[] = {&a};
    hipError_t e = hipLaunchCooperativeKernel((const void*)fwd_megakernel, dim3(grid), dim3(NTHREADS), args, LDS_BYTES, stream);
    if (e != hipSuccess) fprintf(stderr, "kernel_launch: cooperative launch failed: %s (grid %d)\n", hipGetErrorString(e), grid);
}
```

```cpp
#include <hip/hip_runtime.h>
#include <hip/hip_cooperative_groups.h>
#include <cstdio>
#include <cstdint>
#include <cmath>
namespace cg = cooperative_groups;

#define LAS __attribute__((address_space(3)))
typedef unsigned short bf16_t;
typedef short bf16x8 __attribute__((ext_vector_type(8)));
typedef short s16x4 __attribute__((ext_vector_type(4)));
typedef float f32x4 __attribute__((ext_vector_type(4)));
typedef float f32x2 __attribute__((ext_vector_type(2)));
typedef float f32x16 __attribute__((ext_vector_type(16)));
typedef unsigned u32x4 __attribute__((ext_vector_type(4)));
typedef unsigned u32x2 __attribute__((ext_vector_type(2)));

constexpr int S_ = 16384, DM = 2048, DIN = 6208, DINP = 6400, QL = 512;
constexpr int NH = 16, DQK = 192, DN = 128, DR = 64, DV = 128, QW = NH * DQK  , KVW = NH * 256  ;
constexpr int PW = 1024, NMEM = 256, MHD = 512, DFF = 5632, FF2 = 11264, FFH = 2816;
constexpr float EPS = 1e-6f;
constexpr int NTHREADS = 512, NWAVES = 8;

constexpr size_t MiB = 1u << 20;
constexpr size_t WS_W_IN = 0, WS_W_QB = 25 * MiB, WS_W_KVB = 28 * MiB, WS_W_ATT = 32 * MiB, WS_W_PG = 40 * MiB, WS_W_PBR = 41 * MiB,
                 WS_W_MIX = 45 * MiB, WS_W_MQ = 53 * MiB, WS_W_MKV = 61 * MiB, WS_W_MO = 77 * MiB, WS_W_FIN = 85 * MiB, WS_W_FOUT = 129 * MiB;
constexpr size_t WS_ROPE = 151 * MiB, WS_STAT = 155 * MiB, WS_KPE = 157 * MiB, WS_MEMN = 159 * MiB;
constexpr size_t WS_MEMK = 0, WS_VMT = 1 * MiB;
constexpr size_t WS_H3 = 0;
constexpr size_t WS_QC = 160 * MiB, WS_U = 192 * MiB, WS_GA = 224 * MiB, WS_GP = 288 * MiB, WS_D = 352 * MiB, WS_KV = 384 * MiB;
constexpr size_t WS_AO = 160 * MiB, WS_MERGED = 352 * MiB, WS_MO = 160 * MiB, WS_H2 = 288 * MiB, WS_QM = 352 * MiB, WS_PM = 416 * MiB;
constexpr size_t WS_OM = 160 * MiB, WS_MO2 = 224 * MiB, WS_AH = 160 * MiB, WS_ACT = 336 * MiB, WS_MO3 = 160 * MiB;
constexpr size_t WS_END = 512 * MiB;
constexpr size_t DO_H = 0, DO_Q = 0, DO_PD = 96 * MiB;

typedef __bf16 bf16x2_t __attribute__((ext_vector_type(2)));
__device__ __forceinline__ unsigned cvt_pk(float lo, float hi) { f32x2 v = {lo, hi}; bf16x2_t b = __builtin_convertvector(v, bf16x2_t); return __builtin_bit_cast(unsigned, b); }
__device__ __forceinline__ float bf_lo(unsigned u) { return __uint_as_float(u << 16); }
__device__ __forceinline__ float bf_hi(unsigned u) { return __uint_as_float(u & 0xffff0000u); }
__device__ __forceinline__ u32x4 pack8(f32x4 a, f32x4 b) { u32x4 w; w.x = cvt_pk(a[0], a[1]); w.y = cvt_pk(a[2], a[3]); w.z = cvt_pk(b[0], b[1]); w.w = cvt_pk(b[2], b[3]); return w; }
__device__ __forceinline__ void unpack8(u32x4 w, f32x4& a, f32x4& b) { a = (f32x4){bf_lo(w.x), bf_hi(w.x), bf_lo(w.y), bf_hi(w.y)}; b = (f32x4){bf_lo(w.z), bf_hi(w.z), bf_lo(w.w), bf_hi(w.w)}; }
__device__ __forceinline__ float sigmoidf_(float x) { return __builtin_amdgcn_rcpf(1.f + __expf(-x)); }
__device__ __forceinline__ float wave_sum(float v) {
#pragma unroll
    for (int o = 1; o < 64; o <<= 1) v += __shfl_xor(v, o);
    return v;
}
#define LDS_WAIT() asm volatile("s_waitcnt lgkmcnt(0)" ::: "memory")
__device__ __forceinline__ int fresh_tid() { int t = threadIdx.x; asm volatile("" : "+v"(t)); return t; }

namespace pg8 {
constexpr int BM = 256, BK = 64, HALF = 128, HTB = HALF * BK * 2, STAGE_BYTES = 8 * HTB, NXCD = 8, WGM = 8;
__host__ __device__ __forceinline__ int lds_byte(int r, int c) { const int st = (r >> 4) * 2 + (c >> 5), rr = r & 15, cc = c & 31, ob = rr * 64 + cc * 2; return st * 1024 + (ob ^ (((ob >> 9) & 1) << 5)); }
__host__ __device__ __forceinline__ void stage_rc(int b, int& R, int& C) { const int st = b / 1024, sb = b % 1024, swz = sb ^ (((sb >> 9) & 1) << 5); R = (st >> 1) * 16 + swz / 64; C = (st & 1) * 32 + (swz % 64) / 2; }
__host__ __device__ __forceinline__ int perm32(int rho) { const int n = rho >> 4, i = rho & 15; return 8 * (i >> 2) + 4 * n + (i & 3); }

struct Unit { int pm, pn; };
struct Gemm { const bf16_t* A; const bf16_t* Bt; int lda, ldb, K; };

struct Order {
    int nM, nN, nwg, G, c;
    __device__ __forceinline__ void init(int nM_, int nN_, int G_, int bid, int rot) { nM = nM_; nN = nN_; nwg = nM * nN; G = G_; c = (bid + G_ - (rot % G_)) % G_; }
    __device__ __forceinline__ bool next(int i, Unit& u) const {
        const long L = (long)i * G + c; if (L >= nwg) return false;
        int wgid = (int)L; { const int q = nwg / NXCD, r = nwg % NXCD, xcd = wgid % NXCD, off = wgid / NXCD; wgid = (xcd < r ? xcd * (q + 1) : r * (q + 1) + (xcd - r) * q) + off; }
        const int nig = WGM * nN, gid = wgid / nig, fm = gid * WGM, gsz = (nM - fm) < WGM ? (nM - fm) : WGM;
        u.pm = fm + ((wgid % nig) % gsz); u.pn = (wgid % nig) / gsz; return true;
    }
};

template <class Epi, bool APERM = false, bool NARROW = false>
__device__ __forceinline__ void gemm_phase(LAS unsigned char* lds, const Gemm g, const Order& S, const Epi& E) {
    const int tid = fresh_tid(), wid = __builtin_amdgcn_readfirstlane(tid >> 6), lane = tid & 63, wr = wid >> 2, wc = wid & 3, fr = lane & 15, fq = lane >> 4;
    const int K = g.K, nt = K / BK;
    unsigned voffA[2], voffB[2];
#pragma unroll
    for (int i = 0; i < 2; ++i) { int R, C; stage_rc(tid * 16 + i * 8192, R, C); const int Rb = (R & ~31) + perm32(R & 31);
        const int Ra = APERM ? ((R & ~63) + 4 * (R & 15) + ((R >> 4) & 3)) : R;
        voffA[i] = (unsigned)(Ra * g.lda + C) * 2u; voffB[i] = (unsigned)(Rb * g.ldb + C) * 2u; }
    const size_t kstep = (size_t)(BK * 2);
    const size_t hstepA = (size_t)HALF * g.lda * 2, hstepB = (size_t)HALF * g.ldb * 2;
    const size_t tstepA = 2 * hstepA, tstepB = 2 * hstepB;
    const unsigned ldsw = (unsigned)wid * 1024u;
    const int aoff = lds_byte(wr * 64 + fr, fq * 8), boff = lds_byte(wc * 32 + fr, fq * 8);
#define PG8_SA(b, h) (((b) * 2 + (h)) * HTB)
#define PG8_SB(b, h) ((4 + (b) * 2 + (h)) * HTB)
#define PG8_STAGE(bufoff, gbase, voff) do { _Pragma("unroll") for (int _i = 0; _i < 2; ++_i) \
        __builtin_amdgcn_global_load_lds((const unsigned*)((const char*)(gbase) + (voff)[_i]), (LAS unsigned*)(lds + (bufoff) + ldsw + _i * 8192), 16, 0, 0); } while (0)
#define PG8_LDA(dst, b, h) do { _Pragma("unroll") for (int m = 0; m < 4; ++m) _Pragma("unroll") for (int k = 0; k < 2; ++k) dst[m][k] = *(const LAS bf16x8*)(lds + PG8_SA(b, h) + aoff + m * 2048 + k * 1024); } while (0)
#define PG8_LDB(dst, b, h) do { _Pragma("unroll") for (int n = 0; n < 2; ++n) _Pragma("unroll") for (int k = 0; k < 2; ++k) dst[n][k] = *(const LAS bf16x8*)(lds + PG8_SB(b, h) + boff + n * 2048 + k * 1024); } while (0)
#define PG8_MMA(ai, bj, At, Bt) do { __builtin_amdgcn_s_setprio(1); _Pragma("unroll") for (int m = 0; m < 4; ++m) _Pragma("unroll") for (int n = 0; n < 2; ++n) _Pragma("unroll") for (int k = 0; k < 2; ++k) \
        acc[ai][bj][m][n] = __builtin_amdgcn_mfma_f32_16x16x32_bf16(Bt[n][k], At[m][k], acc[ai][bj][m][n], 0, 0, 0); __builtin_amdgcn_s_setprio(0); } while (0)
#define PG8_WAIT_V(n) asm volatile("s_waitcnt vmcnt(" #n ")" ::: "memory")
#define PG8_WAIT_L(n) asm volatile("s_waitcnt lgkmcnt(" #n ")" ::: "memory")
#define PG8_BAR __builtin_amdgcn_s_barrier()
#define PG8_SCHED __builtin_amdgcn_sched_barrier(0)
    Unit cur, nxt; int ui = 0;
    if (!S.next(0, cur)) return;
    f32x4 acc[2][2][4][2];
#pragma unroll
    for (int a = 0; a < 2; ++a)
#pragma unroll
        for (int b = 0; b < 2; ++b)
#pragma unroll
            for (int m = 0; m < 4; ++m)
#pragma unroll
                for (int n = 0; n < 2; ++n) acc[a][b][m][n] = (f32x4){0.f, 0.f, 0.f, 0.f};
    bf16x8 At[4][2], B0[2][2], B1[2][2];
    const char* cA = (const char*)g.A + (size_t)cur.pm * tstepA; const char* cB = (const char*)g.Bt + (size_t)cur.pn * tstepB;
    PG8_STAGE(PG8_SB(0, 0), cB, voffB); PG8_STAGE(PG8_SB(0, 1), cB + hstepB, voffB); PG8_STAGE(PG8_SA(0, 0), cA, voffA); PG8_STAGE(PG8_SA(0, 1), cA + hstepA, voffA);
    if (wr == 1) PG8_BAR;
    PG8_WAIT_V(2); PG8_BAR;
    PG8_STAGE(PG8_SB(1, 0), cB + kstep, voffB); PG8_STAGE(PG8_SA(1, 0), cA + kstep, voffA); PG8_STAGE(PG8_SB(1, 1), cB + hstepB + kstep, voffB);
    PG8_WAIT_V(6); PG8_BAR;
    for (;;) {
        const bool has_next = S.next(ui + 1, nxt);
        bool live0 = true, live1 = true; if constexpr (NARROW) { if (cur.pn == Epi::NARROW_PN) { live1 = false; live0 = wc < 2; } }
        const char* nA = has_next ? (const char*)g.A + (size_t)nxt.pm * tstepA : cA; const char* nB = has_next ? (const char*)g.Bt + (size_t)nxt.pn * tstepB : cB;
        for (int t = 0; t < nt; t += 2) {
            const bool last = (t == nt - 2);
            const char* a1 = cA + (size_t)(t + 1) * kstep;
            const char* a2 = last ? nA : cA + (size_t)(t + 2) * kstep; const char* b2 = last ? nB : cB + (size_t)(t + 2) * kstep;
            const char* a3 = a2 + kstep; const char* b3 = b2 + kstep;
            PG8_LDB(B0, 0, 0); PG8_LDB(B1, 0, 1); PG8_SCHED; PG8_LDA(At, 0, 0); PG8_STAGE(PG8_SA(1, 1), a1 + hstepA, voffA);
            PG8_WAIT_V(8); PG8_WAIT_L(0); PG8_BAR; if (live0) PG8_MMA(0, 0, At, B0); if (live1) PG8_MMA(0, 1, At, B1); PG8_BAR; PG8_SCHED;
            PG8_LDA(At, 0, 1); PG8_STAGE(PG8_SB(0, 0), b2, voffB); PG8_STAGE(PG8_SB(0, 1), b2 + hstepB, voffB); PG8_STAGE(PG8_SA(0, 0), a2, voffA);
            PG8_WAIT_V(8); PG8_WAIT_L(0); PG8_BAR; if (live0) PG8_MMA(1, 0, At, B0); if (live1) PG8_MMA(1, 1, At, B1); PG8_BAR; PG8_SCHED;
            PG8_LDB(B0, 1, 0); PG8_LDB(B1, 1, 1); PG8_SCHED; PG8_LDA(At, 1, 0); PG8_STAGE(PG8_SA(0, 1), a2 + hstepA, voffA);
            PG8_WAIT_V(8); PG8_WAIT_L(0); PG8_BAR; if (live0) PG8_MMA(0, 0, At, B0); if (live1) PG8_MMA(0, 1, At, B1); PG8_BAR; PG8_SCHED;
            PG8_LDA(At, 1, 1); PG8_STAGE(PG8_SB(1, 0), b3, voffB); PG8_STAGE(PG8_SB(1, 1), b3 + hstepB, voffB); PG8_STAGE(PG8_SA(1, 0), a3, voffA);
            PG8_WAIT_V(8); PG8_WAIT_L(0); PG8_BAR; if (live0) PG8_MMA(1, 0, At, B0); if (live1) PG8_MMA(1, 1, At, B1); PG8_BAR; PG8_SCHED;
        }
        if (wr == 0) PG8_BAR;
        E(acc, cur, wr, wc, fr, fq);
        if (!has_next) break;
#pragma unroll
        for (int a = 0; a < 2; ++a)
#pragma unroll
            for (int b = 0; b < 2; ++b)
#pragma unroll
                for (int m = 0; m < 4; ++m)
#pragma unroll
                    for (int n = 0; n < 2; ++n) acc[a][b][m][n] = (f32x4){0.f, 0.f, 0.f, 0.f};
        cur = nxt; cA = nA; cB = nB; ++ui;
        if (wr == 1) PG8_BAR;
    }
    PG8_WAIT_V(0);
    PG8_BAR;
#undef PG8_SA
#undef PG8_SB
#undef PG8_STAGE
#undef PG8_LDA
#undef PG8_LDB
#undef PG8_MMA
#undef PG8_WAIT_V
#undef PG8_WAIT_L
#undef PG8_BAR
#undef PG8_SCHED
}
}
using pg8::Unit;
typedef f32x4 Acc[2][2][4][2];

#define EPI_ARGS const Acc& acc, const Unit& u, int wr, int wc, int fr, int fq
#define EPI_ROWCOL const int row0 = u.pm * 256 + wr * 64 + fr; const int ct0 = wc * 32 + 8 * fq;

struct EpiStore {
    bf16_t* O; int ldo; int coff;
    __device__ __forceinline__ void operator()(EPI_ARGS) const { EPI_ROWCOL
#pragma unroll
        for (int ai = 0; ai < 2; ++ai)
#pragma unroll
            for (int m = 0; m < 4; ++m) { bf16_t* rp = O + (size_t)(row0 + ai * 128 + m * 16) * ldo + coff + u.pn * 256 + ct0;
#pragma unroll
                for (int bj = 0; bj < 2; ++bj) *(u32x4*)(rp + bj * 128) = pack8(acc[ai][bj][m][0], acc[ai][bj][m][1]); }
    }
};
struct EpiIn {
    static constexpr int NARROW_PN = 4;
    bf16_t *QC, *U, *GA, *GP, *KPE; float* STAT; const f32x2* ROPE;
    __device__ __forceinline__ void operator()(EPI_ARGS) const { EPI_ROWCOL
        const int pn = u.pn;
        if (pn < 4) {
#pragma unroll
            for (int ai = 0; ai < 2; ++ai)
#pragma unroll
                for (int m = 0; m < 4; ++m) { const int row = row0 + ai * 128 + m * 16; float s = 0.f;
#pragma unroll
                    for (int bj = 0; bj < 2; ++bj) { const f32x4 v0 = acc[ai][bj][m][0], v1 = acc[ai][bj][m][1];
                        s += (v0[0] * v0[0] + v0[1] * v0[1]) + (v0[2] * v0[2] + v0[3] * v0[3]) + (v1[0] * v1[0] + v1[1] * v1[1]) + (v1[2] * v1[2] + v1[3] * v1[3]);
                        *(u32x4*)(QC + (size_t)row * 1024 + pn * 256 + bj * 128 + ct0) = pack8(v0, v1); }
                    s += __shfl_xor(s, 16); s += __shfl_xor(s, 32);
                    if (fq == 0) STAT[(size_t)row * 32 + pn * 4 + wc] = s; }
        } else if (pn == 4) {
            if (wc < 2) { const int i0 = 16 * wc + 4 * fq;
#pragma unroll
                for (int ai = 0; ai < 2; ++ai)
#pragma unroll
                    for (int m = 0; m < 4; ++m) { const int row = row0 + ai * 128 + m * 16; const f32x4 v0 = acc[ai][0][m][0], v1 = acc[ai][0][m][1];
                        const f32x4 cs0 = *(const f32x4*)(ROPE + (size_t)row * 32 + i0), cs1 = *(const f32x4*)(ROPE + (size_t)row * 32 + i0 + 2);
                        const float a0 = v0[0] * cs0[0] - v0[1] * cs0[1], b0 = v0[1] * cs0[0] + v0[0] * cs0[1];
                        const float a1 = v0[2] * cs0[2] - v0[3] * cs0[3], b1 = v0[3] * cs0[2] + v0[2] * cs0[3];
                        const float a2 = v1[0] * cs1[0] - v1[1] * cs1[1], b2 = v1[1] * cs1[0] + v1[0] * cs1[1];
                        const float a3 = v1[2] * cs1[2] - v1[3] * cs1[3], b3 = v1[3] * cs1[2] + v1[2] * cs1[3];
                        u32x2 wa, wb; wa.x = cvt_pk(a0, a1); wa.y = cvt_pk(a2, a3); wb.x = cvt_pk(b0, b1); wb.y = cvt_pk(b2, b3);
                        *(u32x2*)(KPE + (size_t)row * 64 + i0) = wa; *(u32x2*)(KPE + (size_t)row * 64 + 32 + i0) = wb; } }
        } else if (pn < 9) {
#pragma unroll
            for (int ai = 0; ai < 2; ++ai)
#pragma unroll
                for (int m = 0; m < 4; ++m) { const int row = row0 + ai * 128 + m * 16;
#pragma unroll
                    for (int bj = 0; bj < 2; ++bj) *(u32x4*)(U + (size_t)row * 1024 + (pn - 5) * 256 + bj * 128 + ct0) = pack8(acc[ai][bj][m][0], acc[ai][bj][m][1]); }
        } else {
            bf16_t* G = pn < 17 ? GA : GP; const int pc = (pn < 17 ? pn - 9 : pn - 17) * 256;
#pragma unroll
            for (int ai = 0; ai < 2; ++ai)
#pragma unroll
                for (int m = 0; m < 4; ++m) { const int row = row0 + ai * 128 + m * 16;
#pragma unroll
                    for (int bj = 0; bj < 2; ++bj) { f32x4 v0 = acc[ai][bj][m][0], v1 = acc[ai][bj][m][1];
#pragma unroll
                        for (int e = 0; e < 4; ++e) { v0[e] = sigmoidf_(v0[e]); v1[e] = sigmoidf_(v1[e]); }
                        *(u32x4*)(G + (size_t)row * 2048 + pc + bj * 128 + ct0) = pack8(v0, v1); } }
        }
    }
};
__device__ __forceinline__ float rstd8(const float* st) { const f32x4 a = *(const f32x4*)st, b = *(const f32x4*)(st + 4); const float s = (a[0] + a[1]) + (a[2] + a[3]) + (b[0] + b[1]) + (b[2] + b[3]); return 1.0f / sqrtf(s * (1.0f / 512.0f) + EPS); }
struct EpiQ {
    bf16_t* Q; const float* STAT; const f32x2* ROPE;
    __device__ __forceinline__ void operator()(EPI_ARGS) const { EPI_ROWCOL
        const int pn = u.pn;
#pragma unroll
        for (int ai = 0; ai < 2; ++ai)
#pragma unroll
            for (int m = 0; m < 4; ++m) { const int row = row0 + ai * 128 + m * 16; const float rs = rstd8(STAT + (size_t)row * 32);
                if (pn < 8) {
#pragma unroll
                    for (int bj = 0; bj < 2; ++bj) *(u32x4*)(Q + (size_t)row * QW + (2 * pn + bj) * DQK + ct0) = pack8(acc[ai][bj][m][0] * rs, acc[ai][bj][m][1] * rs);
                } else { const int i0 = 16 * (wc & 1) + 4 * fq;
                    const f32x4 cs0 = *(const f32x4*)(ROPE + (size_t)row * 32 + i0), cs1 = *(const f32x4*)(ROPE + (size_t)row * 32 + i0 + 2);
#pragma unroll
                    for (int bj = 0; bj < 2; ++bj) { const int head = 4 * (pn - 8) + 2 * bj + (wc >> 1); const f32x4 v0 = acc[ai][bj][m][0] * rs, v1 = acc[ai][bj][m][1] * rs;
                        const float a0 = v0[0] * cs0[0] - v0[1] * cs0[1], b0 = v0[1] * cs0[0] + v0[0] * cs0[1];
                        const float a1 = v0[2] * cs0[2] - v0[3] * cs0[3], b1 = v0[3] * cs0[2] + v0[2] * cs0[3];
                        const float a2 = v1[0] * cs1[0] - v1[1] * cs1[1], b2 = v1[1] * cs1[0] + v1[0] * cs1[1];
                        const float a3 = v1[2] * cs1[2] - v1[3] * cs1[3], b3 = v1[3] * cs1[2] + v1[2] * cs1[3];
                        u32x2 wa, wb; wa.x = cvt_pk(a0, a1); wa.y = cvt_pk(a2, a3); wb.x = cvt_pk(b0, b1); wb.y = cvt_pk(b2, b3);
                        bf16_t* qp = Q + (size_t)row * QW + head * DQK + DN + i0; *(u32x2*)qp = wa; *(u32x2*)(qp + 32) = wb; } }
            }
    }
};
struct EpiKV {
    bf16_t* KV; const float* STAT;
    __device__ __forceinline__ void operator()(EPI_ARGS) const { EPI_ROWCOL
#pragma unroll
        for (int ai = 0; ai < 2; ++ai)
#pragma unroll
            for (int m = 0; m < 4; ++m) { const int row = row0 + ai * 128 + m * 16; const float rs = rstd8(STAT + (size_t)row * 32 + 8);
#pragma unroll
                for (int bj = 0; bj < 2; ++bj) *(u32x4*)(KV + (size_t)row * KVW + u.pn * 256 + bj * 128 + ct0) = pack8(acc[ai][bj][m][0] * rs, acc[ai][bj][m][1] * rs); }
    }
};
struct EpiMemKV {
    bf16_t *MEMK, *VMT;
    __device__ __forceinline__ void operator()(EPI_ARGS) const { EPI_ROWCOL
#pragma unroll
        for (int ai = 0; ai < 2; ++ai)
#pragma unroll
            for (int m = 0; m < 4; ++m) { const int row = row0 + ai * 128 + m * 16;
#pragma unroll
                for (int bj = 0; bj < 2; ++bj) { const u32x4 w = pack8(acc[ai][bj][m][0], acc[ai][bj][m][1]); const int col = u.pn * 256 + bj * 128 + ct0;
                    if (u.pn < 8) *(u32x4*)(MEMK + (size_t)row * 2048 + col) = w;
                    else { bf16_t* vp = VMT + (size_t)(col - 2048) * 256 + row;
                        vp[0 * 256] = (bf16_t)(w.x & 0xffff); vp[1 * 256] = (bf16_t)(w.x >> 16); vp[2 * 256] = (bf16_t)(w.y & 0xffff); vp[3 * 256] = (bf16_t)(w.y >> 16);
                        vp[4 * 256] = (bf16_t)(w.z & 0xffff); vp[5 * 256] = (bf16_t)(w.z >> 16); vp[6 * 256] = (bf16_t)(w.w & 0xffff); vp[7 * 256] = (bf16_t)(w.w >> 16); } } }
    }
};
template <int PASS> struct EpiMerge {
    bf16_t* T; const bf16_t* G;
    __device__ __forceinline__ void operator()(EPI_ARGS) const { EPI_ROWCOL
#pragma unroll
        for (int ai = 0; ai < 2; ++ai)
#pragma unroll
            for (int m = 0; m < 4; ++m) { const size_t ro = (size_t)(row0 + ai * 128 + m * 16) * 2048 + u.pn * 256 + ct0;
#pragma unroll
                for (int bj = 0; bj < 2; ++bj) { f32x4 g0, g1; unpack8(*(const u32x4*)(G + ro + bj * 128), g0, g1);
                    f32x4 v0 = acc[ai][bj][m][0] * g0, v1 = acc[ai][bj][m][1] * g1;
                    if (PASS == 1) { f32x4 t0, t1; unpack8(*(const u32x4*)(T + ro + bj * 128), t0, t1); v0 += t0; v1 += t1; }
                    *(u32x4*)(T + ro + bj * 128) = pack8(v0, v1); } }
    }
};
struct EpiF32Stat {
    bf16_t* O; float* STAT;
    __device__ __forceinline__ void operator()(EPI_ARGS) const { EPI_ROWCOL
#pragma unroll
        for (int ai = 0; ai < 2; ++ai)
#pragma unroll
            for (int m = 0; m < 4; ++m) { const int row = row0 + ai * 128 + m * 16; float s = 0.f;
#pragma unroll
                for (int bj = 0; bj < 2; ++bj) { const f32x4 v0 = acc[ai][bj][m][0], v1 = acc[ai][bj][m][1];
                    s += (v0[0] * v0[0] + v0[1] * v0[1]) + (v0[2] * v0[2] + v0[3] * v0[3]) + (v1[0] * v1[0] + v1[1] * v1[1]) + (v1[2] * v1[2] + v1[3] * v1[3]);
                    *(u32x4*)(O + (size_t)row * 2048 + u.pn * 256 + bj * 128 + ct0) = pack8(v0, v1); }
                s += __shfl_xor(s, 16); s += __shfl_xor(s, 32);
                if (fq == 0) STAT[(size_t)row * 32 + u.pn * 4 + wc] = s; }
    }
};
struct EpiSoftmax {
    bf16_t* PM; int coff; LAS f32x2* part;
    __device__ __forceinline__ void operator()(EPI_ARGS) const { EPI_ROWCOL
        constexpr float SC2 = 0.044194173824159216f * 1.4426950408889634f;
        float mloc[2][4];
#pragma unroll
        for (int ai = 0; ai < 2; ++ai)
#pragma unroll
            for (int m = 0; m < 4; ++m) { float mx = -3.0e38f;
#pragma unroll
                for (int bj = 0; bj < 2; ++bj)
#pragma unroll
                    for (int n = 0; n < 2; ++n)
#pragma unroll
                        for (int e = 0; e < 4; ++e) mx = fmaxf(mx, acc[ai][bj][m][n][e]);
                mx = fmaxf(mx, __shfl_xor(mx, 16)); mx = fmaxf(mx, __shfl_xor(mx, 32));
                float s = 0.f;
#pragma unroll
                for (int bj = 0; bj < 2; ++bj)
#pragma unroll
                    for (int n = 0; n < 2; ++n)
#pragma unroll
                        for (int e = 0; e < 4; ++e) s += __builtin_amdgcn_exp2f((acc[ai][bj][m][n][e] - mx) * SC2);
                s += __shfl_xor(s, 16); s += __shfl_xor(s, 32);
                mloc[ai][m] = mx;
                if (fq == 0) part[(ai * 128 + wr * 64 + m * 16 + fr) * 4 + wc] = (f32x2){mx, s}; }
        LDS_WAIT(); __builtin_amdgcn_s_barrier(); asm volatile("" ::: "memory");
#pragma unroll
        for (int ai = 0; ai < 2; ++ai)
#pragma unroll
            for (int m = 0; m < 4; ++m) { const int rl = ai * 128 + wr * 64 + m * 16 + fr;
                const f32x2 p0 = part[rl * 4 + 0], p1 = part[rl * 4 + 1], p2 = part[rl * 4 + 2], p3 = part[rl * 4 + 3];
                const float M = fmaxf(fmaxf(p0.x, p1.x), fmaxf(p2.x, p3.x));
                const float L = p0.y * __builtin_amdgcn_exp2f((p0.x - M) * SC2) + p1.y * __builtin_amdgcn_exp2f((p1.x - M) * SC2) + p2.y * __builtin_amdgcn_exp2f((p2.x - M) * SC2) + p3.y * __builtin_amdgcn_exp2f((p3.x - M) * SC2);
                const float inv = 1.0f / L;
                bf16_t* rp = PM + (size_t)(row0 + ai * 128 + m * 16) * 1024 + coff + ct0;
#pragma unroll
                for (int bj = 0; bj < 2; ++bj) { f32x4 v0 = acc[ai][bj][m][0], v1 = acc[ai][bj][m][1];
#pragma unroll
                    for (int e = 0; e < 4; ++e) { v0[e] = __builtin_amdgcn_exp2f((v0[e] - M) * SC2) * inv; v1[e] = __builtin_amdgcn_exp2f((v1[e] - M) * SC2) * inv; }
                    *(u32x4*)(rp + bj * 128) = pack8(v0, v1); } }
        LDS_WAIT(); __builtin_amdgcn_s_barrier(); asm volatile("" ::: "memory");
    }
};

__device__ __forceinline__ float gelu_tanh(float x) { const float y2 = 1.5957691216057308f * (x + 0.044715f * x * x * x); return x * __builtin_amdgcn_rcpf(1.f + __expf(-y2)); }

template <int CTRL> __device__ __forceinline__ float dppf(float old, float src) { return __int_as_float(__builtin_amdgcn_update_dpp(__float_as_int(old), __float_as_int(src), CTRL, 0xf, 0xf, false)); }
struct EpiFfn {
    bf16_t* ACTp; float* HALO; const float* conv_w; const float* conv_b; LAS float* xbuf;
    __device__ __forceinline__ void operator()(EPI_ARGS) const {
        const int rowb = u.pm * 256 + wr * 64 + 4 * fr; const int ct0 = wc * 32 + 8 * fq;
        const int ch0 = u.pn * 128 + ct0;
#pragma unroll
        for (int ai = 0; ai < 2; ++ai) if (fr == 15) {
#pragma unroll
            for (int bj = 0; bj < 2; ++bj)
#pragma unroll
                for (int n = 0; n < 2; ++n) { *(LAS f32x4*)(xbuf + ((2 * ai + wr) * 2 + 0) * 256 + bj * 128 + ct0 + 4 * n) = acc[ai][bj][2][n]; *(LAS f32x4*)(xbuf + ((2 * ai + wr) * 2 + 1) * 256 + bj * 128 + ct0 + 4 * n) = acc[ai][bj][3][n]; } }
        if (wr == 1 && fr == 15) {
#pragma unroll
            for (int bj = 0; bj < 2; ++bj)
#pragma unroll
                for (int n = 0; n < 2; ++n) { *(f32x4*)(HALO + ((size_t)u.pm * 4 + 2) * FF2 + u.pn * 256 + bj * 128 + ct0 + 4 * n) = acc[1][bj][2][n]; *(f32x4*)(HALO + ((size_t)u.pm * 4 + 3) * FF2 + u.pn * 256 + bj * 128 + ct0 + 4 * n) = acc[1][bj][3][n]; } }
        if (wr == 0 && fr == 0) {
#pragma unroll
            for (int bj = 0; bj < 2; ++bj)
#pragma unroll
                for (int n = 0; n < 2; ++n) { *(f32x4*)(HALO + ((size_t)u.pm * 4 + 0) * FF2 + u.pn * 256 + bj * 128 + ct0 + 4 * n) = acc[0][bj][0][n]; *(f32x4*)(HALO + ((size_t)u.pm * 4 + 1) * FF2 + u.pn * 256 + bj * 128 + ct0 + 4 * n) = acc[0][bj][1][n]; } }
        LDS_WAIT(); __builtin_amdgcn_s_barrier(); asm volatile("" ::: "memory");
#pragma unroll
        for (int n = 0; n < 2; ++n) {
            f32x4 wg[3], wu[3], bg, bu;
#pragma unroll
            for (int k = 0; k < 3; ++k) { wg[k] = *(const f32x4*)(conv_w + (size_t)k * FF2 + ch0 + 4 * n); wu[k] = *(const f32x4*)(conv_w + (size_t)k * FF2 + DFF + ch0 + 4 * n); }
            bg = *(const f32x4*)(conv_b + ch0 + 4 * n); bu = *(const f32x4*)(conv_b + DFF + ch0 + 4 * n);
#pragma unroll
            for (int ai = 0; ai < 2; ++ai) { const int c = 2 * ai + wr;
                f32x4 cv[2][4];
#pragma unroll
                for (int bj = 0; bj < 2; ++bj) { f32x4 h1 = (f32x4){0.f, 0.f, 0.f, 0.f}, h0 = h1;
                    if (c > 0) { h0 = *(const LAS f32x4*)(xbuf + ((c - 1) * 2 + 0) * 256 + bj * 128 + ct0 + 4 * n); h1 = *(const LAS f32x4*)(xbuf + ((c - 1) * 2 + 1) * 256 + bj * 128 + ct0 + 4 * n); }
                    const f32x4 x0 = acc[ai][bj][0][n], x1 = acc[ai][bj][1][n], x2 = acc[ai][bj][2][n], x3 = acc[ai][bj][3][n]; f32x4 s3, s2;
#pragma unroll
                    for (int e = 0; e < 4; ++e) { s3[e] = dppf<0x111>(h1[e], x3[e]); s2[e] = dppf<0x111>(h0[e], x2[e]); }
                    const f32x4 w0 = bj == 0 ? wg[0] : wu[0], w1 = bj == 0 ? wg[1] : wu[1], w2 = bj == 0 ? wg[2] : wu[2], bb = bj == 0 ? bg : bu;
                    cv[bj][0] = bb + w0 * s2 + w1 * s3 + w2 * x0;
                    cv[bj][1] = bb + w0 * s3 + w1 * x0 + w2 * x1;
                    cv[bj][2] = bb + w0 * x0 + w1 * x1 + w2 * x2;
                    cv[bj][3] = bb + w0 * x1 + w1 * x2 + w2 * x3; }
#pragma unroll
                for (int m = 0; m < 4; ++m) { f32x4 o;
#pragma unroll
                    for (int e = 0; e < 4; ++e) o[e] = gelu_tanh(cv[0][m][e]) * cv[1][m][e];
                    u32x2 w; w.x = cvt_pk(o[0], o[1]); w.y = cvt_pk(o[2], o[3]);
                    *(u32x2*)(ACTp + (size_t)(rowb + ai * 128 + m) * DFF + ch0 + 4 * n) = w; } } }
    }
};

namespace att {
constexpr int NW = 8, QBLK = 32, KVBLK = 64, QB = 256;
constexpr int SHM_V = 16384, SHM_K = 16384, SHM_R = 16384;
constexpr int NBUF = 3;
constexpr int LDS_BYTES = NBUF * (SHM_V + SHM_K + SHM_R) + NW * 64 * 4;
constexpr float SCALE = 0.07216878364870323f;
constexpr float THR = 8.f;
#define KSWZ(row, colB) ((row) * 256 + ((colB) ^ (((row) & 7) << 4)))
#define SBAR() __builtin_amdgcn_sched_barrier(0)
__device__ __forceinline__ int v_st(int k, int c) { const int kk = (k & ~0xC) | ((k & 4) << 1) | ((k & 8) >> 1); return ((kk >> 3) * 4 + (c >> 5)) * 512 + ((kk & 7) * 32 + (c & 31)) * 2; }
__device__ __forceinline__ int v_rd_base(int lane) { return ((lane & 3) << 3) | (((lane >> 2) & 3) << 6) | (((lane >> 4) & 1) << 5) | (((lane >> 5) & 1) << 8); }
constexpr int v_rd_off(int d0, int ks, int half) { return d0 * 512 + ks * 4096 + half * 2048; }
__device__ __forceinline__ int crow(int r, int hi) { return (r & 3) + 8 * (r >> 2) + 4 * hi; }
__device__ __forceinline__ bf16x8 load8(const bf16_t* p) { return *reinterpret_cast<const bf16x8*>(p); }
__device__ __forceinline__ void mask_tile(f32x16& p0, f32x16& p1, int dq) {
    const float NEG = -__builtin_inff();
#pragma unroll
    for (int r = 0; r < 16; ++r) { const int c = (r & 3) + 8 * (r >> 2); if (dq - c < 0) p0[r] = NEG; if (dq - c - 32 < 0) p1[r] = NEG; }
}
__device__ __forceinline__ void partialSM(f32x16& p0, f32x16& p1, float& m_reg, float& mn, float& alpha) {
    float pmax = p0[0];
#pragma unroll
    for (int r = 1; r < 16; ++r) pmax = fmaxf(pmax, p0[r]);
#pragma unroll
    for (int r = 0; r < 16; ++r) pmax = fmaxf(pmax, p1[r]);
    { auto rr = __builtin_amdgcn_permlane32_swap(__float_as_uint(pmax), __float_as_uint(pmax), false, false); pmax = fmaxf(__uint_as_float(rr[0]), __uint_as_float(rr[1])); }
    constexpr float C2 = 1.4426950408889634f * SCALE;
    if (__builtin_expect(__all((pmax - m_reg) * SCALE <= THR), 1)) { mn = m_reg; alpha = 1.f; }
    else { mn = fmaxf(m_reg, pmax); alpha = __builtin_amdgcn_exp2f((m_reg - mn) * C2); m_reg = mn; }
    const float mnL = -mn * C2;
#pragma unroll
    for (int r = 0; r < 16; ++r) p0[r] = fmaf(p0[r], C2, mnL);
#pragma unroll
    for (int r = 0; r < 16; ++r) p1[r] = fmaf(p1[r], C2, mnL);
#pragma unroll
    for (int r = 0; r < 16; ++r) p0[r] = __builtin_amdgcn_exp2f(p0[r]);
}
__device__ __forceinline__ void finishSM(f32x16& p0, f32x16& p1, float alpha, float& l_reg, bf16x8& pa0, bf16x8& pa1, bf16x8& pa2, bf16x8& pa3) {
#pragma unroll
    for (int r = 0; r < 16; ++r) p1[r] = __builtin_amdgcn_exp2f(p1[r]);
    float ps = 0;
#pragma unroll
    for (int r = 0; r < 16; ++r) ps += p0[r];
#pragma unroll
    for (int r = 0; r < 16; ++r) ps += p1[r];
    { auto rr = __builtin_amdgcn_permlane32_swap(__float_as_uint(ps), __float_as_uint(ps), false, false); ps = __uint_as_float(rr[0]) + __uint_as_float(rr[1]); }
    l_reg = l_reg * alpha + ps;
#define PK4(P, B_, OUT) do { unsigned a0 = cvt_pk(P[B_+0], P[B_+1]), a1 = cvt_pk(P[B_+2], P[B_+3]);                          \
        unsigned b0 = cvt_pk(P[B_+4], P[B_+5]), b1 = cvt_pk(P[B_+6], P[B_+7]);                                             \
        auto r0 = __builtin_amdgcn_permlane32_swap(a0, b0, false, false); auto r1 = __builtin_amdgcn_permlane32_swap(a1, b1, false, false); \
        u32x4 w = {r0[0], r1[0], r0[1], r1[1]}; OUT = *reinterpret_cast<bf16x8*>(&w); } while (0)
    PK4(p0, 0, pa0); PK4(p0, 8, pa1); PK4(p1, 0, pa2); PK4(p1, 8, pa3);
#undef PK4
}
__device__ __forceinline__ void qkt(f32x16& p0, f32x16& p1, const LAS char* Kb, int r32, int hi, const bf16x8* qr) {
    p0 = f32x16{}; p1 = f32x16{};
    const LAS char* kb[4];
#pragma unroll
    for (int dd = 0; dd < 4; ++dd) kb[dd] = Kb + KSWZ(r32, (dd * 16 + hi * 8) * 2);
#pragma unroll
    for (int d0 = 0; d0 < 12; ++d0) { const LAS char* a = kb[d0 & 3] + (d0 < 8 ? (d0 >> 2) * 128 : NBUF * SHM_K);
        if (d0 != 0 && (d0 & 1) == 0) SBAR();
        bf16x8 b0 = *reinterpret_cast<const LAS bf16x8*>(a);
        bf16x8 b1 = *reinterpret_cast<const LAS bf16x8*>(a + 32 * 256);
        p0 = __builtin_amdgcn_mfma_f32_32x32x16_bf16(b0, qr[d0], p0, 0, 0, 0);
        p1 = __builtin_amdgcn_mfma_f32_32x32x16_bf16(b1, qr[d0], p1, 0, 0, 0); }
}
__device__ __forceinline__ void pv_tile(f32x16* o, int vb0, bf16x8 pa0, bf16x8 pa1, bf16x8 pa2, bf16x8 pa3) {
#define TRRD(dst, off) asm volatile("ds_read_b64_tr_b16 %0, %1 offset:%2" : "=&v"(dst) : "v"(vb0), "i"(off) : "memory")
#define PV_D0(d0) do { s16x4 l0, l1, l2, l3, h0, h1, h2, h3; constexpr int b_ = v_rd_off(d0, 0, 0); \
        TRRD(l0, b_); TRRD(h0, b_ + 2048); TRRD(l1, b_ + 4096); TRRD(h1, b_ + 6144); TRRD(l2, b_ + 8192); TRRD(h2, b_ + 10240); TRRD(l3, b_ + 12288); TRRD(h3, b_ + 14336); \
        asm volatile("s_waitcnt lgkmcnt(0)" ::: "memory"); SBAR();   \
        o[d0] = __builtin_amdgcn_mfma_f32_32x32x16_bf16((bf16x8){l0[0], l0[1], l0[2], l0[3], h0[0], h0[1], h0[2], h0[3]}, pa0, o[d0], 0, 0, 0);   \
        o[d0] = __builtin_amdgcn_mfma_f32_32x32x16_bf16((bf16x8){l1[0], l1[1], l1[2], l1[3], h1[0], h1[1], h1[2], h1[3]}, pa1, o[d0], 0, 0, 0);   \
        o[d0] = __builtin_amdgcn_mfma_f32_32x32x16_bf16((bf16x8){l2[0], l2[1], l2[2], l2[3], h2[0], h2[1], h2[2], h2[3]}, pa2, o[d0], 0, 0, 0);   \
        o[d0] = __builtin_amdgcn_mfma_f32_32x32x16_bf16((bf16x8){l3[0], l3[1], l3[2], l3[3], h3[0], h3[1], h3[2], h3[3]}, pa3, o[d0], 0, 0, 0); } while (0)
    PV_D0(0); PV_D0(1); PV_D0(2); PV_D0(3);
#undef PV_D0
#undef TRRD
}
struct ARef { unsigned qoff, kvoff; bf16_t* O; int P0; int rev; };
struct Seam { bf16x8 qr[12]; int bt; };
struct Rsrc { __amdgpu_buffer_rsrc_t q, kv, r; };
__device__ __forceinline__ bf16x8 bload(__amdgpu_buffer_rsrc_t rs, unsigned voff, unsigned soff) { return __builtin_bit_cast(bf16x8, __builtin_amdgcn_raw_buffer_load_b128(rs, (int)voff, (int)soff, 0)); }
#define VMW() asm volatile("s_waitcnt vmcnt(0)" ::: "memory")
#define DMA_TILE(kvoff_, k0, bo) do { const int so_ = (int)((unsigned)(k0) * (KVW * 2) + (kvoff_)), sr2_ = (int)((unsigned)(k0) * (DR * 2));   \
        _Pragma("unroll") for (int j_ = 0; j_ < 2; ++j_) { const int pc_ = (bo) + (2 * wid + j_) * 1024;                                      \
            __builtin_amdgcn_raw_ptr_buffer_load_lds(RS.kv, (LAS void*)(K_lds + pc_), 16, voffK[j_], so_, 0, 0);                              \
            __builtin_amdgcn_raw_ptr_buffer_load_lds(RS.kv, (LAS void*)(V_lds + pc_), 16, voffV[j_], so_, 0, 0);                              \
            __builtin_amdgcn_raw_ptr_buffer_load_lds(RS.r, (LAS void*)(R_lds + pc_), 16, voffR[j_], sr2_, 0, 0); } } while (0)
#define DMA_OFFS int voffK[2], voffV[2], voffR[2];                                                                                             \
    _Pragma("unroll") for (int j_ = 0; j_ < 2; ++j_) { const int p_ = (2 * wid + j_) * 1024 + lane * 16;                                      \
        { const int row = p_ >> 8, pos = (p_ >> 4) & 15, lc = (pos & 8) | ((pos ^ row) & 7); voffK[j_] = row * (KVW * 2) + lc * 16; }            \
        { const int sub = p_ >> 9, kkh = sub >> 2, cblk = sub & 3, wi = p_ & 511, kkl = wi >> 6, cl = (wi & 63) >> 1, c = cblk * 32 + cl, kk = kkh * 8 + kkl, \
              k = (kk & ~0xC) | ((kk & 4) << 1) | ((kk & 8) >> 1); voffV[j_] = k * (KVW * 2) + (128 + c) * 2; }                                \
        { const int row = p_ >> 8, pos = (p_ >> 4) & 7, lc = (pos ^ row) & 7; voffR[j_] = row * (DR * 2) + lc * 16; } }
__device__ __forceinline__ void attn_prime(const ARef& cur, const Rsrc& RS, LAS char* lds, Seam& S) {
    const int tid = fresh_tid(), wid = __builtin_amdgcn_readfirstlane(tid >> 6), lane = tid & 63, r32 = lane & 31, hi = lane >> 5;
    const unsigned vq0 = (unsigned)((wid * QBLK + r32) * QW + hi * 8) * 2u;
    LAS char* V_lds = lds; LAS char* K_lds = lds + NBUF * SHM_V; LAS char* R_lds = lds + NBUF * (SHM_V + SHM_K);
    DMA_OFFS
#pragma unroll
    for (int d0 = 0; d0 < 12; ++d0) S.qr[d0] = bload(RS.q, vq0, cur.qoff + d0 * 32);
    DMA_TILE(cur.kvoff, (cur.rev ? (cur.P0 + QB) / KVBLK - 1 : 0) * KVBLK, 0); VMW(); S.bt = 0;
    __syncthreads();
}
__device__ __forceinline__ void attn_block(const ARef& cur, const ARef& nxt, const Rsrc& RS, LAS char* lds, Seam& S) {
    const int tid = fresh_tid(), wid = __builtin_amdgcn_readfirstlane(tid >> 6), lane = tid & 63, r32 = lane & 31, hi = lane >> 5;
    const int NT = (cur.P0 + QB) / KVBLK;
    const int qlo = cur.P0 + wid * QBLK, qm = qlo + r32 - 4 * hi;
    LAS char* V_lds = lds; LAS char* K_lds = lds + NBUF * SHM_V; LAS char* R_lds = lds + NBUF * (SHM_V + SHM_K);
    float m_reg = -1e30f, l_reg = 0; f32x16 o[4] = {};
    const unsigned vq0 = (unsigned)((wid * QBLK + r32) * QW + hi * 8) * 2u;
    DMA_OFFS
    const int vb0 = (int)(unsigned)(uintptr_t)V_lds + v_rd_base(lane);
    int bt = S.bt;
#define RESC(a) do { if (__any((a) < 1.f)) { _Pragma("unroll") for (int d_ = 0; d_ < 4; ++d_) o[d_] = o[d_] * (a); } } while (0)
#define MASKT(P0_, P1_, t) do { const int kb_ = (t) * KVBLK; if (kb_ + KVBLK - 1 > qlo) mask_tile(P0_, P1_, qm - kb_); } while (0)
#define TILE_OF(t) (rev ? NT - 1 - (t) : (t))
#define STAGE_NEXT(t, bo) do { if ((t) + 1 < NT) { DMA_TILE(cur.kvoff, TILE_OF((t) + 1) * KVBLK, bo); } else { DMA_TILE(nxt.kvoff, nxt_first * KVBLK, bo); } } while (0)
#define QNEXT(t) do { if ((t) + 1 >= NT) { _Pragma("unroll") for (int d0 = 0; d0 < 12; ++d0) S.qr[d0] = bload(RS.q, vq0, nxt.qoff + d0 * 32); } } while (0)
    const bool lag = wid >= 4;
    const int rev = cur.rev, nxt_first = nxt.rev ? (nxt.P0 + QB) / KVBLK - 1 : 0;
    f32x16 p0, p1; float mn, al; bf16x8 pa0, pa1, pa2, pa3;
#define STEP(t, FIRST) do { const int bn = bt == NBUF - 1 ? 0 : bt + 1, bp = bt == 0 ? NBUF - 1 : bt - 1;                              \
        SBAR();                                                                                                              \
        if (lag && !(FIRST)) { pv_tile(o, vb0 + bp * SHM_V, pa0, pa1, pa2, pa3); SBAR(); }                                   \
        qkt(p0, p1, K_lds + bt * SHM_K, r32, hi, S.qr); SBAR();                                                             \
        STAGE_NEXT(t, bn * SHM_V); SBAR();     \
        QNEXT(t); SBAR();                                                                                                    \
        MASKT(p0, p1, TILE_OF(t)); partialSM(p0, p1, m_reg, mn, al); if (!(FIRST)) RESC(al);                               \
        finishSM(p0, p1, al, l_reg, pa0, pa1, pa2, pa3); SBAR();                                                             \
        if (!lag) { pv_tile(o, vb0 + bt * SHM_V, pa0, pa1, pa2, pa3); SBAR(); }                                              \
        VMW(); __syncthreads(); bt = bn; } while (0)
    STEP(0, true);
#pragma unroll 1
    for (int t = 1; t < NT; ++t) STEP(t, false);
    if (lag) { const int bp = bt == 0 ? NBUF - 1 : bt - 1; pv_tile(o, vb0 + bp * SHM_V, pa0, pa1, pa2, pa3); SBAR(); }
#undef STEP
    S.bt = bt;
    {
        const float inv = __builtin_amdgcn_rcpf(l_reg);
        bf16_t* Orow = cur.O + (size_t)(wid * QBLK + r32) * DM + (hi ? 8 : 0);
#pragma unroll
        for (int d0 = 0; d0 < 4; ++d0)
#pragma unroll
            for (int gp = 0; gp < 2; ++gp) { const int ra = 8 * gp, rb = 8 * gp + 4;
                unsigned ax = cvt_pk(o[d0][ra] * inv, o[d0][ra + 1] * inv), ay = cvt_pk(o[d0][ra + 2] * inv, o[d0][ra + 3] * inv);
                unsigned bx = cvt_pk(o[d0][rb] * inv, o[d0][rb + 1] * inv), by = cvt_pk(o[d0][rb + 2] * inv, o[d0][rb + 3] * inv);
                auto sx = __builtin_amdgcn_permlane32_swap(ax, bx, false, false); auto sy = __builtin_amdgcn_permlane32_swap(ay, by, false, false);
                u32x4 w = {sx[0], sy[0], sx[1], sy[1]};
                *(u32x4*)(Orow + d0 * 32 + 16 * gp) = w; }
    }
#undef RESC
#undef MASKT
#undef STAGE_NEXT
#undef TILE_OF
#undef QNEXT
}
#undef VMW
__device__ __forceinline__ ARef make_ref(int L, int pass, bf16_t* O) {
    const int h = L >> 5, x = L & 31, qb = pass ? x : 63 - x;
    ARef r; r.qoff = (unsigned)(qb * QB * QW + h * DQK) * 2u; r.kvoff = (unsigned)(h * 256) * 2u; r.O = O + (size_t)qb * QB * DM + h * DV; r.P0 = qb * QB; r.rev = pass;
    return r;
}
__device__ __forceinline__ void attn_phase(LAS char* lds, const bf16_t* Q, const bf16_t* KV, const bf16_t* KPE, bf16_t* O, int vcu, int G) {
    constexpr int TOTAL = 512;
    int L = vcu; if (L >= TOTAL) return;
    int pass = 0;
    Rsrc RS; RS.q = __builtin_amdgcn_make_buffer_rsrc((void*)Q, 0, 0x7fffffff, 0x00020000); RS.kv = __builtin_amdgcn_make_buffer_rsrc((void*)KV, 0, 0x7fffffff, 0x00020000); RS.r = __builtin_amdgcn_make_buffer_rsrc((void*)KPE, 0, 0x7fffffff, 0x00020000);
    ARef cur = make_ref(L, 0, O);
    Seam S;
    if (__builtin_amdgcn_readfirstlane((int)threadIdx.x >> 6) < 4) __builtin_amdgcn_s_setprio(2); else __builtin_amdgcn_s_setprio(0);
    attn_prime(cur, RS, lds, S);
    for (;;) {
        const bool more_pass = pass == 0, more_item = L + G < TOTAL, last = !more_pass && !more_item;
        int passn = pass + 1, Ln = L;
        if (!more_pass) { passn = 0; Ln = more_item ? L + G : L; }
        const ARef nxt = last ? cur : make_ref(Ln, passn, O);
        attn_block(cur, nxt, RS, lds, S);
        if (last) { __builtin_amdgcn_s_setprio(0); break; }
        cur = nxt; pass = passn; L = Ln;
    }
}
#undef KSWZ
#undef SBAR
}

struct Args { const void* in[27]; float* out; unsigned char* ws; float inv_freq[32]; };

template <class Map>
__device__ __forceinline__ void transpose_item(const float* W, int K, int N, bf16_t* WT, int nblk, LAS float* scr, int item, int lane, Map map, const float* kscale, const float* nscale) {
    const int kb = item / nblk, nb = item % nblk, k0 = 64 * kb, n0 = 32 * nb;
    const int src = map(n0 + (lane & 31));
    const float ns = (src >= 0 && nscale) ? nscale[src] : 1.f;
    const int src0 = map(n0);
    if (src0 >= 0 && (src0 & 3) == 0 && (N & 3) == 0 && __all(src == src0 + (lane & 31)) && !nscale) {
        const int kr = lane >> 3, nq = lane & 7;
#pragma unroll
        for (int i = 0; i < 8; ++i) { const int kk = 8 * i + kr; f32x4 v = __builtin_nontemporal_load((const f32x4*)(W + (size_t)(k0 + kk) * N + src0 + 4 * nq)); if (kscale) v = v * kscale[k0 + kk];
            LAS float* d = scr + kk * 33 + 4 * nq; d[0] = v[0]; d[1] = v[1]; d[2] = v[2]; d[3] = v[3]; }
    } else {
#pragma unroll 8
    for (int i = 0; i < 32; ++i) { const int kk = 2 * i + (lane >> 5); float v = src >= 0 ? __builtin_nontemporal_load(&W[(size_t)(k0 + kk) * N + src]) : 0.f;     v *= ns; if (kscale) v *= kscale[k0 + kk]; scr[kk * 33 + (lane & 31)] = v; }
    }
    LDS_WAIT(); asm volatile("" ::: "memory");
    const int c = lane & 7;
#pragma unroll
    for (int j = 0; j < 4; ++j) { const int n = (lane >> 3) + 8 * j; const LAS float* s = scr + (8 * c) * 33 + n;
        u32x4 o; o.x = cvt_pk(s[0 * 33], s[1 * 33]); o.y = cvt_pk(s[2 * 33], s[3 * 33]); o.z = cvt_pk(s[4 * 33], s[5 * 33]); o.w = cvt_pk(s[6 * 33], s[7 * 33]);
        *(u32x4*)(WT + (size_t)(n0 + n) * K + k0 + 8 * c) = o; }
    LDS_WAIT(); asm volatile("" ::: "memory");
}
struct MapId { __device__ __forceinline__ int operator()(int n) const { return n; } };
struct MapIn { __device__ __forceinline__ int operator()(int n) const { if (n < 1024) return n; if (n < 1280) { const int j = n - 1024; if (j >= 64) return -1; return 1024 + ((j & 1) ? 32 + (j >> 1) : (j >> 1)); } return n - 1280 + 1088; } };
struct MapQ { __device__ __forceinline__ int operator()(int n) const { if (n < 2048) return (n >> 7) * DQK + (n & 127); const int j = n - 2048, head = j >> 6, jj = j & 63, i = jj >> 1; return head * DQK + DN + ((jj & 1) ? i + 32 : i); } };
struct MapFfn { __device__ __forceinline__ int operator()(int n) const { const int tile = n >> 8, r = n & 255, ch = 128 * tile + (r & 127); return r < 128 ? ch : DFF + ch; } };

__device__ __forceinline__ void rms_row_bf16(const float* xrow, const float* g, bf16_t* orow, int lane) {
    f32x4 v[8]; float s = 0.f;
#pragma unroll
    for (int j = 0; j < 8; ++j) { v[j] = *(const f32x4*)(xrow + 4 * lane + 256 * j); s += (v[j][0] * v[j][0] + v[j][1] * v[j][1]) + (v[j][2] * v[j][2] + v[j][3] * v[j][3]); }
    const float rstd = 1.0f / sqrtf(wave_sum(s) * (1.0f / DM) + EPS);
#pragma unroll
    for (int j = 0; j < 8; ++j) { const f32x4 gg = *(const f32x4*)(g + 4 * lane + 256 * j); const f32x4 y = v[j] * rstd * gg;
        u32x2 w; w.x = cvt_pk(y[0], y[1]); w.y = cvt_pk(y[2], y[3]); *(u32x2*)(orow + 4 * lane + 256 * j) = w; }
}
template <bool SECOND>
__device__ __forceinline__ void resid_row(const float* xi, const bf16_t* mo, const float* stat, const float* gpost, float* xo, const float* gpre, bf16_t* hrow, int lane) {
    const float st = stat[lane & 31]; float ss = st;
#pragma unroll
    for (int o = 1; o < 32; o <<= 1) ss += __shfl_xor(ss, o);
    const float rstd = 1.0f / sqrtf(ss * (1.0f / DM) + EPS);
    f32x4 v[8]; float s = 0.f;
#pragma unroll
    for (int j = 0; j < 8; ++j) { const int c = 4 * lane + 256 * j; const u32x2 mw = __builtin_nontemporal_load((const u32x2*)(mo + c)); const f32x4 a = __builtin_nontemporal_load((const f32x4*)(xi + c)),     b = (f32x4){bf_lo(mw.x), bf_hi(mw.x), bf_lo(mw.y), bf_hi(mw.y)}, gg = *(const f32x4*)(gpost + c);
        v[j] = a + b * rstd * gg; s += (v[j][0] * v[j][0] + v[j][1] * v[j][1]) + (v[j][2] * v[j][2] + v[j][3] * v[j][3]); *(f32x4*)(xo + c) = v[j]; }
    if (SECOND) { const float r2 = 1.0f / sqrtf(wave_sum(s) * (1.0f / DM) + EPS);
#pragma unroll
        for (int j = 0; j < 8; ++j) { const int c = 4 * lane + 256 * j; const f32x4 gg = *(const f32x4*)(gpre + c); const f32x4 y = v[j] * r2 * gg;
            u32x2 w; w.x = cvt_pk(y[0], y[1]); w.y = cvt_pk(y[2], y[3]); *(u32x2*)(hrow + c) = w; } }
}

#define W_IN ((bf16_t*)(ws + WS_W_IN))
#define W_QB ((bf16_t*)(ws + WS_W_QB))
#define W_KVB ((bf16_t*)(ws + WS_W_KVB))
#define W_ATT ((bf16_t*)(ws + WS_W_ATT))
#define W_PG ((bf16_t*)(ws + WS_W_PG))
#define W_PBR ((bf16_t*)(ws + WS_W_PBR))
#define W_MIX ((bf16_t*)(ws + WS_W_MIX))
#define W_MQ ((bf16_t*)(ws + WS_W_MQ))
#define W_MKV ((bf16_t*)(ws + WS_W_MKV))
#define W_MO ((bf16_t*)(ws + WS_W_MO))
#define W_FIN ((bf16_t*)(ws + WS_W_FIN))
#define W_FOUT ((bf16_t*)(ws + WS_W_FOUT))
#define ROPE ((f32x2*)(ws + WS_ROPE))
#define STAT ((float*)(ws + WS_STAT))
#define KPE ((bf16_t*)(ws + WS_KPE))
#define MEMN ((bf16_t*)(ws + WS_MEMN))
#define MEMKV ((bf16_t*)(ws + WS_MEMK))
#define WKT ((bf16_t*)(ws + 452 * MiB))
#define VWT ((bf16_t*)(ws + 448 * MiB))
#define H3 ((bf16_t*)(ws + WS_H3))
#define QC ((bf16_t*)(ws + WS_QC))
#define U ((bf16_t*)(ws + WS_U))
#define GA ((bf16_t*)(ws + WS_GA))
#define GP ((bf16_t*)(ws + WS_GP))
#define D ((bf16_t*)(dob + DO_PD))
#define W_PCT ((bf16_t*)(ws + 4 * MiB))
#define KV ((bf16_t*)(ws + WS_KV))
#define AO ((bf16_t*)(ws + WS_AO))
#define MERGED ((bf16_t*)(ws + WS_MERGED))
#define MO ((bf16_t*)(ws + WS_MO))
#define H2 ((bf16_t*)(ws + WS_H2))
#define QM ((bf16_t*)(ws + WS_QM))
#define PM ((bf16_t*)(ws + WS_PM))
#define OM ((bf16_t*)(ws + WS_OM))
#define MO2 ((bf16_t*)(ws + WS_MO2))
#define AH ((bf16_t*)(ws + WS_AH))
#define ACT ((bf16_t*)(ws + WS_ACT))
#define MO3 ((bf16_t*)(ws + WS_MO3))
#define H ((bf16_t*)(dob + DO_H))
#define Q ((bf16_t*)(dob + DO_Q))


#define XB_TMO      128
#define XB_XCNT(j)  (256  + 64 * (j))
#define XB_XSUB(j)  (1280 + 64 * (j))
#define XB_XGEN(j)  (2304 + 64 * (j))
#define XB_TOP      3328
#define XB_TOPGEN   3392
#define XCD_BAR_WORDS 3456
#define XB_SPIN_CAP (1u << 20)
__device__ unsigned g_bar[XCD_BAR_WORDS];
__device__ __forceinline__ unsigned xb_ld(unsigned* p)              { return __hip_atomic_load(p, __ATOMIC_RELAXED, __HIP_MEMORY_SCOPE_AGENT); }
__device__ __forceinline__ unsigned xb_add(unsigned* p, unsigned v) { return __hip_atomic_fetch_add(p, v, __ATOMIC_RELAXED, __HIP_MEMORY_SCOPE_AGENT); }
__device__ __forceinline__ unsigned xb_xcc_id() { return (unsigned)__builtin_amdgcn_s_getreg((3 << 11) | 20) & 0xFu; }
#define XB_SPIN(cond, bar) do { unsigned _sp = 0; while (cond) { __builtin_amdgcn_s_sleep(1); \
    if ((++_sp & 255u) == 0u) { if (xb_ld(&(bar)[XB_TMO])) break; if (_sp > XB_SPIN_CAP) { atomicAdd(&(bar)[XB_TMO], 1u); break; } } } } while (0)
struct XcdBarrier { unsigned* bar; unsigned x; volatile LAS unsigned* st; };
__device__ __forceinline__ XcdBarrier xcd_barrier_post(unsigned* bar, volatile LAS unsigned* st) {
    XcdBarrier b; b.bar = bar; b.x = xb_xcc_id(); b.st = st;
    if (threadIdx.x == 0) (void)xb_add(&bar[XB_XCNT(b.x)], 1u);
    return b;
}
__device__ __forceinline__ void xcd_barrier_complete(unsigned* bar, unsigned x, unsigned& nloc, unsigned& nx) {
    const unsigned G = gridDim.x * gridDim.y * gridDim.z;
    unsigned sum, cnt, mine, sp = 0u;
    for (;;) {
        sum = 0u; cnt = 0u; mine = 0u;
#pragma unroll
        for (unsigned j = 0; j < 16; ++j) { const unsigned c = xb_ld(&bar[XB_XCNT(j)]); sum += c; cnt += (c > 0u) ? 1u : 0u; mine = (j == x) ? c : mine; }
        if (sum == G) break;
        __builtin_amdgcn_s_sleep(1);
        if ((++sp & 255u) == 0u) { if (xb_ld(&bar[XB_TMO])) break; if (sp > XB_SPIN_CAP) { atomicAdd(&bar[XB_TMO], 1u); break; } }
    }
    nloc = mine > 0u ? mine : 1u; nx = cnt > 0u ? cnt : 1u;
}
__device__ __forceinline__ void xcd_barrier(const XcdBarrier& b) {
    asm volatile("s_waitcnt vmcnt(0)" ::: "memory");
    __syncthreads();
    if (threadIdx.x == 0) {
        unsigned* bar = b.bar;
        __builtin_amdgcn_s_waitcnt(0);
        unsigned nloc = b.st[0], nx = b.st[1];
        if (nloc == 0u) { xcd_barrier_complete(bar, b.x, nloc, nx); b.st[0] = nloc; b.st[1] = nx; }
        const unsigned old = xb_add(&bar[XB_XSUB(b.x)], 1u);
        const unsigned gen = old / nloc;
        if (old + 1u == (gen + 1u) * nloc) {
            __builtin_amdgcn_fence(__ATOMIC_RELEASE, "agent");
            asm volatile("s_waitcnt vmcnt(0)" ::: "memory");
            const unsigned og = xb_add(&bar[XB_TOP], 1u);
            const unsigned tg = og / nx;
            if (og + 1u == (tg + 1u) * nx) xb_add(&bar[XB_TOPGEN], 1u);
            else XB_SPIN(xb_ld(&bar[XB_TOPGEN]) == tg, bar);
            __builtin_amdgcn_fence(__ATOMIC_ACQUIRE, "agent");
            xb_add(&bar[XB_XGEN(b.x)], 1u);
            asm volatile("s_waitcnt vmcnt(0)" ::: "memory");
        } else {
            XB_SPIN(xb_ld(&bar[XB_XGEN(b.x)]) == gen, bar);
            __builtin_amdgcn_fence(__ATOMIC_ACQUIRE, "agent");
            asm volatile("s_waitcnt vmcnt(0)" ::: "memory");
        }
    }
    __syncthreads();
}
__global__ void __launch_bounds__(NTHREADS) fwd_megakernel(Args a) {
    extern __shared__ __attribute__((aligned(16))) unsigned char lds_raw[];
    cg::grid_group grid = cg::this_grid();
    LAS unsigned char* lds = (LAS unsigned char*)lds_raw;
    const int G = gridDim.x, bid = blockIdx.x;
    if (bid == 0) for (int u_ = threadIdx.x; u_ < XCD_BAR_WORDS; u_ += NTHREADS) g_bar[u_] = 0u;
    volatile LAS unsigned* bar_st = (volatile LAS unsigned*)(lds + (152 * 1024 - 64));
    if (threadIdx.x < 2) bar_st[threadIdx.x] = 0u;
    __syncthreads();
    const int vcu = (G % 8 == 0) ? (bid % 8) * (G / 8) + bid / 8 : bid;
    const int NGW = G * NWAVES, NGT = G * NTHREADS;
#define PHASE_IDS const int tid = fresh_tid(), lane = tid & 63, wave = __builtin_amdgcn_readfirstlane(tid >> 6), gw = bid * NWAVES + wave, gt = bid * NTHREADS + tid; (void)lane; (void)gw; (void)gt;
    unsigned char* ws = a.ws; unsigned char* dob = (unsigned char*)a.out;
    const float* x = (const float*)a.in[0];
#ifndef ATT_ONLY
    {
        PHASE_IDS
        LAS float* scr = (LAS float*)(lds + wave * 8704);
        const float* w_in = (const float*)a.in[4]; const float* g_q_a = (const float*)a.in[5]; const float* w_q_b = (const float*)a.in[6]; const float* g_kv_a = (const float*)a.in[7];
        const float* w_kv_b = (const float*)a.in[8]; const float* w_attn_br = (const float*)a.in[9]; const float* w_pool_grp = (const float*)a.in[10]; const float* pool_scale = (const float*)a.in[11];
        const float* w_pool_br = (const float*)a.in[12]; const float* w_mix_out = (const float*)a.in[13]; const float* w_mem_q = (const float*)a.in[17]; const float* w_mem_kv = (const float*)a.in[18];
        const float* w_mem_o = (const float*)a.in[19]; const float* w_ffn_in = (const float*)a.in[22]; const float* w_ffn_out = (const float*)a.in[25];
        constexpr int I_IN = 32 * (DINP / 32), I_QB = 8 * (QW / 32), I_KVB = 8 * (KVW / 32), I_SQ = 32 * 64, I_PG = 256, I_PBR = 16 * 64, I_MKV = 32 * 128, I_FIN = 32 * (FF2 / 32), I_FOUT = 88 * 64;
        constexpr int NITEMS = I_IN + I_QB + I_KVB + I_SQ + 4 * I_PG + I_PBR + I_SQ + I_SQ + I_MKV + I_SQ + I_FIN + I_FOUT;
        for (int it = gw; it < NITEMS; it += NGW) {
            int r = it;
            if (r < I_IN) { transpose_item(w_in, DM, DIN, W_IN, DINP / 32, scr, r, lane, MapIn(), nullptr, nullptr); continue; } r -= I_IN;
            if (r < I_QB) { transpose_item(w_q_b, QL, QW, W_QB, QW / 32, scr, r, lane, MapQ(), g_q_a, nullptr); continue; } r -= I_QB;
            if (r < I_KVB) { transpose_item(w_kv_b, QL, KVW, W_KVB, KVW / 32, scr, r, lane, MapId(), g_kv_a, nullptr); continue; } r -= I_KVB;
            if (r < I_SQ) { transpose_item(w_attn_br, DM, DM, W_ATT, 64, scr, r, lane, MapId(), nullptr, nullptr); continue; } r -= I_SQ;
            if (r < 4 * I_PG) {
                const f32x4 v = *(const f32x4*)(w_pool_grp + (size_t)r * 256 + 4 * lane) * *(const f32x4*)(pool_scale + (r >> 8) * 256 + 4 * lane);
                u32x2 w; w.x = cvt_pk(v[0], v[1]); w.y = cvt_pk(v[2], v[3]); *(u32x2*)(W_PG + (size_t)r * 256 + 4 * lane) = w; continue; } r -= 4 * I_PG;
            if (r < I_PBR) { transpose_item(w_pool_br, PW, DM, W_PBR, 64, scr, r, lane, MapId(), nullptr, nullptr); continue; } r -= I_PBR;
            if (r < I_SQ) { transpose_item(w_mix_out, DM, DM, W_MIX, 64, scr, r, lane, MapId(), nullptr, nullptr); continue; } r -= I_SQ;
            if (r < I_SQ) {
#pragma unroll
                for (int j = 0; j < 8; ++j) { const f32x4 v = __builtin_nontemporal_load((const f32x4*)(w_mem_q + (size_t)r * DM + 4 * lane + 256 * j)); u32x2 w; w.x = cvt_pk(v[0], v[1]); w.y = cvt_pk(v[2], v[3]); *(u32x2*)(W_MQ + (size_t)r * DM + 4 * lane + 256 * j) = w; }
                continue; } r -= I_SQ;
            if (r < I_MKV) { transpose_item(w_mem_kv, DM, 4096, W_MKV, 128, scr, r, lane, MapId(), nullptr, nullptr); continue; } r -= I_MKV;
            if (r < I_SQ) { transpose_item(w_mem_o, DM, DM, W_MO, 64, scr, r, lane, MapId(), nullptr, nullptr); continue; } r -= I_SQ;
            if (r < I_FIN) { transpose_item(w_ffn_in, DM, FF2, W_FIN, FF2 / 32, scr, r, lane, MapFfn(), nullptr, nullptr); continue; } r -= I_FIN;
            transpose_item(w_ffn_out, DFF, DM, W_FOUT, 64, scr, r, lane, MapId(), nullptr, nullptr);
        }
        const float* g_mix_pre = (const float*)a.in[3]; const float* mem = (const float*)a.in[1]; const float* g_mem_kv = (const float*)a.in[16];
        for (int m = gw; m < S_; m += NGW) rms_row_bf16(x + (size_t)m * DM, g_mix_pre, H + (size_t)m * DM, lane);
        for (int m = gw; m < NMEM; m += NGW) rms_row_bf16(mem + (size_t)m * DM, g_mem_kv, MEMN + (size_t)m * DM, lane);
        const int* pos = (const int*)a.in[2];
        for (int e = gt; e < S_ * 32; e += NGT) { const int row = e >> 5, i = e & 31; const float ang = (float)pos[row] * a.inv_freq[i];
            double rev = (double)ang * 0.15915494309189535; rev -= floor(rev); const float rf = (float)rev;
            ROPE[e] = (f32x2){__builtin_amdgcn_cosf(rf), __builtin_amdgcn_sinf(rf)}; }
    }
    grid.sync();
    const XcdBarrier xbar = xcd_barrier_post(g_bar, bar_st);

    { pg8::Gemm g{H, W_IN, DM, DM, DM}; pg8::Order S; S.init(64, 25, G, bid, 0); EpiIn E{QC, U, GA, GP, KPE, STAT, ROPE}; pg8::gemm_phase<EpiIn, false, true>(lds, g, S, E); }
    xcd_barrier(xbar);

    {
        PHASE_IDS
        for (int it = gt; it < 128 * 1024; it += NGT) { const int cgp = it & 127, chunk = it >> 7, t0 = chunk * 16, c = cgp * 8, w = 2 << (cgp >> 5);
            float sum[8];
#pragma unroll
            for (int e = 0; e < 8; ++e) sum[e] = 0.f;
            for (int k = 1; k < w; ++k) { const int t = t0 - k; if (t >= 0) { f32x4 p, q; unpack8(*(const u32x4*)(U + (size_t)t * PW + c), p, q);
#pragma unroll
                for (int e = 0; e < 4; ++e) { sum[e] += p[e]; sum[4 + e] += q[e]; } } }
            for (int r = 0; r < 16; ++r) { const int t = t0 + r; f32x4 p, q; unpack8(*(const u32x4*)(U + (size_t)t * PW + c), p, q);
#pragma unroll
                for (int e = 0; e < 4; ++e) { sum[e] += p[e]; sum[4 + e] += q[e]; }
                const float ic = 1.0f / (float)(t + 1 < w ? t + 1 : w); f32x4 d0, d1;
#pragma unroll
                for (int e = 0; e < 4; ++e) { d0[e] = sum[e] * ic - p[e]; d1[e] = sum[4 + e] * ic - q[e]; }
                *(u32x4*)(D + (size_t)t * PW + c) = pack8(d0, d1);
                const int tt = t - w + 1; if (tt >= 0) { f32x4 p2, q2; unpack8(*(const u32x4*)(U + (size_t)tt * PW + c), p2, q2);
#pragma unroll
                    for (int e = 0; e < 4; ++e) { sum[e] -= p2[e]; sum[4 + e] -= q2[e]; } } } }
        { pg8::Gemm g{QC, W_QB, 1024, QL, QL}; pg8::Order S; S.init(64, 12, G, bid, 0); EpiQ E{Q, STAT, ROPE}; pg8::gemm_phase(lds, g, S, E); }
        { pg8::Gemm g{QC + 512, W_KVB, 1024, QL, QL}; pg8::Order S; S.init(64, 16, G, bid, 0); EpiKV E{KV, STAT}; pg8::gemm_phase(lds, g, S, E); }
        { pg8::Gemm g{MEMN, W_MKV, DM, DM, DM}; pg8::Order S; S.init(1, 16, G, bid, 0); EpiStore E{MEMKV, 4096, 0}; pg8::gemm_phase(lds, g, S, E); }
#pragma unroll 1
        for (int gi = 0; gi < 4; ++gi) { pg8::Gemm g{W_PBR + gi * 256, W_PG + gi * 65536, PW, 256, 256}; pg8::Order S; S.init(8, 1, G, bid, 16 + gi * 8); EpiStore E{W_PCT, PW, gi * 256}; pg8::gemm_phase(lds, g, S, E); }
    }
    xcd_barrier(xbar);

#endif
    {
#ifndef ATT_ONLY
#endif
#ifndef NO_ATT
        att::attn_phase((LAS char*)lds, Q, KV, KPE, AO, vcu, G);
#endif
    }
    xcd_barrier(xbar);

#ifndef ATT_ONLY
    { pg8::Gemm g{AO, W_ATT, DM, DM, DM}; pg8::Order S; S.init(64, 8, G, bid, 0); EpiMerge<0> E{MERGED, GA}; pg8::gemm_phase(lds, g, S, E); }
    { pg8::Gemm g{D, W_PCT, PW, PW, PW}; pg8::Order S; S.init(64, 8, G, bid, 0); EpiMerge<1> E{MERGED, GP}; pg8::gemm_phase(lds, g, S, E); }
    xcd_barrier(xbar);

    { pg8::Gemm g{MERGED, W_MIX, DM, DM, DM}; pg8::Order S; S.init(64, 8, G, bid, 0); EpiF32Stat E{MO, STAT}; pg8::gemm_phase(lds, g, S, E); }
    xcd_barrier(xbar);

#pragma unroll 1
    for (int h = 0; h < 4; ++h) { pg8::Gemm g{W_MO + h * MHD, MEMKV + 2048 + h * MHD, DM, 4096, MHD}; pg8::Order S; S.init(8, 1, G, bid, h * 8); EpiStore E{VWT, 1024, h * 256}; pg8::gemm_phase(lds, g, S, E); }
#pragma unroll 1
    for (int h = 0; h < 4; ++h) { pg8::Gemm g{MEMKV + h * MHD, W_MQ + h * MHD, 4096, DM, MHD}; pg8::Order S; S.init(1, 8, G, bid, 32 + h * 8); EpiStore E{WKT + (size_t)h * 256 * DM, DM, 0}; pg8::gemm_phase(lds, g, S, E); }
    { PHASE_IDS for (int m = gw; m < S_; m += NGW) resid_row<true>(x + (size_t)m * DM, MO + (size_t)m * DM, STAT + (size_t)m * 32, (const float*)a.in[14], a.out + (size_t)m * DM, (const float*)a.in[15], H2 + (size_t)m * DM, lane); }
    xcd_barrier(xbar);

#pragma unroll 1
    for (int h = 0; h < 4; ++h) { pg8::Gemm g{H2, WKT + (size_t)h * 256 * DM, DM, DM, DM}; pg8::Order S; S.init(64, 1, G, bid, h * 64); EpiSoftmax E{PM, h * 256, (LAS f32x2*)(lds + pg8::STAGE_BYTES)}; pg8::gemm_phase(lds, g, S, E); }
    xcd_barrier(xbar);

    { pg8::Gemm g{PM, VWT, 1024, 1024, 1024}; pg8::Order S; S.init(64, 8, G, bid, 0); EpiF32Stat E{MO2, STAT}; pg8::gemm_phase(lds, g, S, E); }
    xcd_barrier(xbar);

    { PHASE_IDS for (int m = gw; m < S_; m += NGW) resid_row<true>(a.out + (size_t)m * DM, MO2 + (size_t)m * DM, STAT + (size_t)m * 32, (const float*)a.in[20], a.out + (size_t)m * DM, (const float*)a.in[21], H3 + (size_t)m * DM, lane); }
    xcd_barrier(xbar);

    { pg8::Gemm g{H3, W_FIN, DM, DM, DM}; pg8::Order S; S.init(64, 44, G, bid, 0); EpiFfn E{ACT, (float*)(ws + WS_AH), (const float*)a.in[23], (const float*)a.in[24], (LAS float*)(lds + pg8::STAGE_BYTES)}; pg8::gemm_phase<EpiFfn, true>(lds, g, S, E); }
    xcd_barrier(xbar);
    {
        PHASE_IDS
        const float* conv_w = (const float*)a.in[23]; const float* conv_b = (const float*)a.in[24]; const float* HALO = (const float*)(ws + WS_AH);
        for (int it = gt; it < 63 * 2 * 704; it += NGT) { const int cg8 = it % 704, rr = (it / 704) & 1, pm = 1 + it / 1408, tile = cg8 >> 4, c = (cg8 & 15) * 8, ch = tile * 128 + c, gcol = tile * 256 + c;
            const float* r0 = HALO + ((size_t)pm * 4 + rr) * FF2; const float* r1 = rr ? HALO + ((size_t)pm * 4 + 0) * FF2 : HALO + ((size_t)(pm - 1) * 4 + 3) * FF2; const float* r2 = rr ? HALO + ((size_t)(pm - 1) * 4 + 3) * FF2 : HALO + ((size_t)(pm - 1) * 4 + 2) * FF2;
            f32x4 o[2];
#pragma unroll
            for (int q = 0; q < 2; ++q) { const int cc = gcol + 4 * q, jj = ch + 4 * q;
                const f32x4 cgv = *(const f32x4*)(conv_b + jj) + *(const f32x4*)(conv_w + jj) * *(const f32x4*)(r2 + cc) + *(const f32x4*)(conv_w + FF2 + jj) * *(const f32x4*)(r1 + cc) + *(const f32x4*)(conv_w + 2 * (size_t)FF2 + jj) * *(const f32x4*)(r0 + cc);
                const f32x4 cuv = *(const f32x4*)(conv_b + DFF + jj) + *(const f32x4*)(conv_w + DFF + jj) * *(const f32x4*)(r2 + cc + 128) + *(const f32x4*)(conv_w + FF2 + DFF + jj) * *(const f32x4*)(r1 + cc + 128) + *(const f32x4*)(conv_w + 2 * (size_t)FF2 + DFF + jj) * *(const f32x4*)(r0 + cc + 128);
#pragma unroll
                for (int e = 0; e < 4; ++e) o[q][e] = gelu_tanh(cgv[e]) * cuv[e]; }
            *(u32x4*)(ACT + (size_t)(pm * 256 + rr) * DFF + ch) = pack8(o[0], o[1]); }
    }
    xcd_barrier(xbar);
    { pg8::Gemm g{ACT, W_FOUT, DFF, DFF, DFF}; pg8::Order S; S.init(64, 8, G, bid, 0); EpiF32Stat E{MO3, STAT}; pg8::gemm_phase(lds, g, S, E); }
    xcd_barrier(xbar);

    { PHASE_IDS for (int m = gw; m < S_; m += NGW) resid_row<false>(a.out + (size_t)m * DM, MO3 + (size_t)m * DM, STAT + (size_t)m * 32, (const float*)a.in[26], a.out + (size_t)m * DM, nullptr, nullptr, lane); }
#endif
}

constexpr int LDS_BYTES = 152 * 1024;
static_assert(att::LDS_BYTES <= LDS_BYTES - 64 && pg8::STAGE_BYTES + 8192 <= LDS_BYTES - 64, "LDS map");
extern "C" void kernel_launch(void* const* d_in, const int* in_sizes, int n_in, void* d_out, int out_size, void* d_ws, size_t ws_size, hipStream_t stream) {
    static int grid = 0;
    if (grid == 0) {
        if (n_in != 27 || in_sizes[0] != S_ * DM || out_size != S_ * DM || ws_size < WS_END) { fprintf(stderr, "kernel_launch: unexpected shapes (n_in %d, in0 %d, out %d, ws %zu)\n", n_in, n_in > 0 ? in_sizes[0] : -1, out_size, ws_size); grid = -1; return; }
        int dev = 0, cus = 0, per_cu = 0;
        (void)hipGetDevice(&dev); (void)hipDeviceGetAttribute(&cus, hipDeviceAttributeMultiprocessorCount, dev);
        if (hipFuncSetAttribute((const void*)fwd_megakernel, hipFuncAttributeMaxDynamicSharedMemorySize, LDS_BYTES) != hipSuccess) { fprintf(stderr, "kernel_launch: hipFuncSetAttribute failed\n"); grid = -1; return; }
        if (hipOccupancyMaxActiveBlocksPerMultiprocessor(&per_cu, (const void*)fwd_megakernel, NTHREADS, LDS_BYTES) != hipSuccess || per_cu < 1) { fprintf(stderr, "kernel_launch: occupancy query gave %d\n", per_cu); per_cu = 1; }
        (void)hipGetLastError();
        if (cus <= 0) cus = 256;
        grid = cus * (per_cu > 1 ? 1 : per_cu);
    }
    if (grid < 0) return;
    Args a{};
    for (int i = 0; i < 27; ++i) a.in[i] = d_in[i];
    a.out = (float*)d_out; a.ws = (unsigned char*)d_ws;
    for (int i = 0; i < 32; ++i) a.inv_freq[i] = (float)pow(10000.0, -(double)i / 32.0);
    void* args[] = {&a};
    hipError_t e = hipLaunchCooperativeKernel((const void*)fwd_megakernel, dim3(grid), dim3(NTHREADS), args, LDS_BYTES, stream);
    if (e != hipSuccess) fprintf(stderr, "kernel_launch: cooperative launch failed: %s (grid %d)\n", hipGetErrorString(e), grid);
}
```
